# Optimizing an MI355X kernel written in HIP

```python
import math
import jax
import jax.numpy as jnp
from jax import lax
import numpy as np

D_MODEL = 1024
BATCH = 4
SEQ = 8192
DEPTH = 4

GRID_W = 64
CTX_LEN = 256
Q_BLOCK = 128
ROPE_BASE = 10000.0
LN_EPS = 1e-5
RMS_EPS = 1e-6
DEEPNORM_ALPHA = (2.0 * DEPTH) ** 0.25
DEEPNORM_BETA = (8.0 * DEPTH) ** -0.25

DA_HEADS = 4
DA_QK = 64
DA_V = 128
DA_WIDTH = DA_HEADS * DA_V
DA_SCALE = DA_QK ** -0.5
MLA_HEADS = 8
MLA_Q_RANK = 256
MLA_KV_RANK = 128
MLA_NOPE = 64
MLA_ROPE = 32
MLA_V = 64
MLA_WIDTH = MLA_HEADS * MLA_V
MLA_SCALE = (MLA_NOPE + MLA_ROPE) ** -0.5
ML_HEADS = 4
ML_DH = 128
ML_WIDTH = ML_HEADS * ML_DH
ML_CONV = 5
ML_CHUNK = 128
NA_HEADS = 8
NA_DH = 64
NA_WIDTH = NA_HEADS * NA_DH
NA_ROWS = 8
NA_COLS = 16
NA_SCALE = NA_DH ** -0.5

EVEN_WIDTH = DA_WIDTH + MLA_WIDTH
ODD_WIDTH = ML_WIDTH + NA_WIDTH
EVEN_SPLIT = [DA_HEADS * DA_QK] * 4 + [DA_WIDTH, MLA_Q_RANK, MLA_KV_RANK, MLA_ROPE, EVEN_WIDTH]
ODD_SPLIT = [2 * ML_WIDTH, ML_WIDTH, ML_WIDTH, 4 * ML_HEADS, NA_WIDTH, NA_WIDTH, NA_WIDTH, ODD_WIDTH]
EVEN_IN = sum(EVEN_SPLIT)
ODD_IN = sum(ODD_SPLIT)
N_EVEN = (DEPTH + 1) // 2
N_ODD = DEPTH // 2
F32 = jnp.float32

kernel_name = 'hybrid_diffattn_mla_mlstm_natten_prefix'


def split_cols(z, sizes):
    return jnp.split(z, np.cumsum(sizes)[:-1].tolist(), axis=-1)


def to_heads(t, n):
    b, s, e = t.shape
    return t.reshape(b, s, n, e // n).transpose(0, 2, 1, 3)


def from_heads(t):
    b, n, s, d = t.shape
    return t.transpose(0, 2, 1, 3).reshape(b, s, n * d)


def layer_norm(x, g, b):
    xf = x.astype(F32)
    mu = jnp.mean(xf, -1, keepdims=True)
    var = jnp.mean(jnp.square(xf - mu), -1, keepdims=True)
    return ((xf - mu) * lax.rsqrt(var + LN_EPS) * g.astype(F32) + b.astype(F32)).astype(x.dtype)


def head_layer_norm(x):
    xf = x.astype(F32)
    mu = jnp.mean(xf, -1, keepdims=True)
    var = jnp.mean(jnp.square(xf - mu), -1, keepdims=True)
    return ((xf - mu) * lax.rsqrt(var + LN_EPS)).astype(x.dtype)


def rms_norm(x, g):
    xf = x.astype(F32)
    return (xf * lax.rsqrt(jnp.mean(xf * xf, -1, keepdims=True) + RMS_EPS) * g.astype(F32)).astype(x.dtype)


def adaln(cond, w, b):
    m = jnp.einsum('...d,de->...e', jax.nn.silu(cond), w) + b
    return jnp.split(m, 3, axis=-1)


def axial_rope(n_tokens, dim):
    t = jnp.arange(n_tokens)
    row = (t // GRID_W).astype(F32)
    col = (t % GRID_W).astype(F32)
    n_freq = dim // 4
    freqs = ROPE_BASE ** (-jnp.arange(n_freq, dtype=F32) / n_freq)
    ang = jnp.concatenate([row[:, None] * freqs, col[:, None] * freqs], axis=-1)
    return jnp.cos(ang), jnp.sin(ang)


def apply_rope(x, cos, sin):
    half = x.shape[-1] // 2
    xf = x.astype(F32)
    x1, x2 = xf[..., :half], xf[..., half:]
    return jnp.concatenate([x1 * cos - x2 * sin, x2 * cos + x1 * sin], axis=-1).astype(x.dtype)


def _to_blocks(q):
    b, h, s, d = q.shape
    return q.reshape(b, h, s // Q_BLOCK, Q_BLOCK, d).transpose(2, 0, 1, 3, 4)


def _from_blocks(o):
    nb, b, h, qb, d = o.shape
    return o.transpose(1, 2, 0, 3, 4).reshape(b, h, nb * qb, d)


def blocked_queries(fn, *qs):
    out = lax.map(lambda blk: fn(*blk), tuple(_to_blocks(q) for q in qs))
    return _from_blocks(out)


def softmax_attention(q, k, v, scale):
    def one(qb):
        s = jnp.einsum('bhqd,bhkd->bhqk', qb, k).astype(F32) * scale
        p = jax.nn.softmax(s, axis=-1).astype(v.dtype)
        return jnp.einsum('bhqk,bhkd->bhqd', p, v)
    return blocked_queries(one, q)


def diff_attention(q1, q2, k1, k2, v, lam):
    def one(a, b_):
        s1 = jnp.einsum('bhqd,bhkd->bhqk', a, k1).astype(F32) * DA_SCALE
        s2 = jnp.einsum('bhqd,bhkd->bhqk', b_, k2).astype(F32) * DA_SCALE
        p = jax.nn.softmax(s1, axis=-1) - lam * jax.nn.softmax(s2, axis=-1)
        return jnp.einsum('bhqk,bhkd->bhqd', p.astype(v.dtype), v)
    return blocked_queries(one, q1, q2)


def even_project(h, w_in, b_in, q_norm_g, kv_norm_g, w_uq, w_ukv, rope_da, rope_mla):
    z = jnp.einsum('bsd,de->bse', h, w_in) + b_in
    q1, q2, k1, k2, v, cq, ckv, k_rope, gate = split_cols(z, EVEN_SPLIT)
    q1, q2, k1, k2 = (to_heads(t, DA_HEADS) for t in (q1, q2, k1, k2))
    v = to_heads(v, DA_HEADS)
    qm = to_heads(jnp.einsum('bsr,re->bse', rms_norm(cq, q_norm_g), w_uq), MLA_HEADS)
    kvm = to_heads(jnp.einsum('bsr,re->bse', rms_norm(ckv, kv_norm_g), w_ukv), MLA_HEADS)
    q_nope, q_rope = qm[..., :MLA_NOPE], qm[..., MLA_NOPE:]
    k_nope, vm = kvm[..., :MLA_NOPE], kvm[..., MLA_NOPE:]
    k_rope = k_rope[:, None]
    if rope_da is not None:
        q1, q2, k1, k2 = (apply_rope(t, *rope_da) for t in (q1, q2, k1, k2))
        q_rope = apply_rope(q_rope, *rope_mla)
        k_rope = apply_rope(k_rope, *rope_mla)
    qm = jnp.concatenate([q_nope, q_rope], axis=-1)
    km = jnp.concatenate([k_nope, jnp.broadcast_to(k_rope, k_nope.shape[:-1] + (MLA_ROPE,))], axis=-1)
    return (q1, q2, qm, gate), (k1, k2, v, km, vm)


def even_mix(queries, keys, lam, lam_init, subln_g, w_out):
    q1, q2, qm, gate = queries
    k1, k2, vd, km, vm = keys
    oa = rms_norm(diff_attention(q1, q2, k1, k2, vd, lam), subln_g) * (1.0 - lam_init)
    ob = softmax_attention(qm, km, vm, MLA_SCALE)
    y = jnp.concatenate([from_heads(oa), from_heads(ob)], axis=-1) * jax.nn.silu(gate)
    return jnp.einsum('bse,ed->bsd', y, w_out)


def centred_depthwise_conv(x, w, b):
    y = lax.conv_general_dilated(x, w[:, None, :].astype(x.dtype), window_strides=(1,),
                                 padding=[(ML_CONV // 2, ML_CONV // 2)],
                                 dimension_numbers=('NWC', 'WIO', 'NWC'),
                                 feature_group_count=x.shape[-1])
    return y + b


def odd_project(h, w_in, b_in, conv_w, conv_b, f_bias):
    b, s, _ = h.shape
    z = jnp.einsum('bsd,de->bse', h, w_in) + b_in
    qk, v, o, gates, qn, kn, vn, gate = split_cols(z, ODD_SPLIT)
    qk = jax.nn.silu(centred_depthwise_conv(qk, conv_w, conv_b))
    q = to_heads(qk[..., :ML_WIDTH], ML_HEADS)
    k = to_heads(qk[..., ML_WIDTH:], ML_HEADS) * (ML_DH ** -0.5)
    v = to_heads(v, ML_HEADS)
    g = gates.astype(F32).reshape(b, s, 4, ML_HEADS).transpose(2, 0, 3, 1)
    fb = f_bias.astype(F32)
    fwd = (g[0], jax.nn.log_sigmoid(g[1] + fb[0][:, None]))
    bwd = (g[2], jax.nn.log_sigmoid(g[3] + fb[1][:, None]))
    na = tuple(t.reshape(b, s, NA_HEADS, NA_DH) for t in (qn, kn, vn))
    return (q, k, v, jax.nn.sigmoid(o), fwd, bwd), na, gate


def zero_state(b):
    return (jnp.zeros((b, ML_HEADS, ML_DH, ML_DH), F32), jnp.zeros((b, ML_HEADS, ML_DH), F32),
            jnp.zeros((b, ML_HEADS), F32))


def mlstm_chunkwise(q, k, v, log_i, log_f, state, with_output=True):
    b, nh, s, d = q.shape
    nc = s // ML_CHUNK

    def chunks(t):
        return jnp.moveaxis(t.reshape(t.shape[:2] + (nc, ML_CHUNK) + t.shape[3:]), 2, 0)

    lower = jnp.tril(jnp.ones((ML_CHUNK, ML_CHUNK), dtype=bool))

    def step(carry, inp):
        c_mat, n_vec, m_sc = carry
        qb, kb, vb, li, lf = inp
        qb, kb, vb = qb.astype(F32), kb.astype(F32), vb.astype(F32)
        bcum = jnp.cumsum(lf, axis=-1)
        btot = bcum[..., -1]
        g = btot[..., None] - bcum + li
        m_new = jnp.maximum(btot + m_sc, jnp.max(g, axis=-1))
        w_s = jnp.exp(g - m_new[..., None])
        decay = jnp.exp(btot + m_sc - m_new)
        c_new = decay[..., None, None] * c_mat + jnp.einsum('bhs,bhsd,bhse->bhde', w_s, kb, vb)
        n_new = decay[..., None] * n_vec + jnp.einsum('bhs,bhsd->bhd', w_s, kb)
        if not with_output:
            return (c_new, n_new, m_new), None
        dmat = jnp.where(lower, bcum[..., :, None] - bcum[..., None, :] + li[..., None, :], -jnp.inf)
        inter = bcum + m_sc[..., None]
        m_t = jnp.maximum(inter, jnp.max(dmat, axis=-1))
        w_ts = jnp.exp(dmat - m_t[..., None]) * jnp.einsum('bhtd,bhsd->bhts', qb, kb)
        w_c = jnp.exp(inter - m_t)
        num = jnp.einsum('bhts,bhsd->bhtd', w_ts, vb) + w_c[..., None] * jnp.einsum('bhtd,bhde->bhte', qb, c_mat)
        den = jnp.sum(w_ts, axis=-1) + w_c * jnp.einsum('bhtd,bhd->bht', qb, n_vec)
        h_t = num / jnp.maximum(jnp.abs(den), jnp.exp(-m_t))[..., None]
        return (c_new, n_new, m_new), h_t.astype(v.dtype)

    state, hs = lax.scan(step, state, tuple(chunks(t) for t in (q, k, v, log_i, log_f)))
    if not with_output:
        return None, state
    return jnp.moveaxis(hs, 0, 2).reshape(b, nh, s, d), state


def flip_seq(t):
    return jnp.flip(t, axis=2)


def mlstm_bidirectional(ml, state_f, state_b, with_output=True):
    q, k, v, _, (li_f, lf_f), (li_b, lf_b) = ml
    h_f, st_f = mlstm_chunkwise(q, k, v, li_f, lf_f, state_f, with_output)
    h_b, st_b = mlstm_chunkwise(flip_seq(q), flip_seq(k), flip_seq(v), flip_seq(li_b), flip_seq(lf_b),
                                state_b, with_output)
    h = h_f + flip_seq(h_b) if with_output else None
    return h, st_f, st_b


def neighbourhood_attention(q, k, v, k_ctx, v_ctx, rpb, rows):
    b, s, h, d = q.shape
    wr = min(NA_ROWS, rows)
    n_nb = wr * NA_COLS
    qg, kg, vg = (t.reshape(b, rows, GRID_W, h, d) for t in (q, k, v))
    col = jnp.arange(GRID_W)
    col_start = jnp.clip(col - NA_COLS // 2, 0, GRID_W - NA_COLS)
    col_idx = col_start[:, None] + jnp.arange(NA_COLS)[None, :]
    col_off = col_idx - col[:, None] + (NA_COLS - 1)

    def one_row(r):
        rs = jnp.clip(r - wr // 2, 0, rows - wr)
        k_nb = lax.dynamic_slice_in_dim(kg, rs, wr, axis=1)[:, :, col_idx]
        v_nb = lax.dynamic_slice_in_dim(vg, rs, wr, axis=1)[:, :, col_idx]
        q_r = lax.dynamic_index_in_dim(qg, r, axis=1, keepdims=False)
        row_off = rs + jnp.arange(wr) - r + (NA_ROWS - 1)
        bias = rpb[:, row_off][:, :, col_off].transpose(0, 2, 1, 3).astype(F32)
        s_nb = jnp.einsum('bqhd,brqjhd->bhqrj', q_r, k_nb).astype(F32) * NA_SCALE + bias
        s_cx = jnp.einsum('bqhd,bthd->bhqt', q_r, k_ctx).astype(F32) * NA_SCALE
        p = jax.nn.softmax(jnp.concatenate([s_nb.reshape(b, h, GRID_W, n_nb), s_cx], axis=-1), axis=-1)
        p = p.astype(v.dtype)
        p_nb = p[..., :n_nb].reshape(b, h, GRID_W, wr, NA_COLS)
        return (jnp.einsum('bhqrj,brqjhd->bqhd', p_nb, v_nb)
                + jnp.einsum('bhqt,bthd->bqhd', p[..., n_nb:], v_ctx))

    o = lax.map(one_row, jnp.arange(rows))
    return o.transpose(1, 0, 2, 3, 4).reshape(b, s, h, d)


def odd_mix(h_ml, o_gate, na_out, gate, norm_g, w_out):
    b, s = na_out.shape[:2]
    y_ml = from_heads(head_layer_norm(h_ml)) * norm_g * o_gate
    y = jnp.concatenate([y_ml, na_out.reshape(b, s, NA_WIDTH)], axis=-1) * jax.nn.silu(gate)
    return jnp.einsum('bse,ed->bsd', y, w_out)


def setup_inputs(seed: int = 0) -> dict:
    key = jax.random.key(seed)
    ks = iter(jax.random.split(key, 32))

    def nrm(shape, scale):
        return jax.random.normal(next(ks), shape, F32) * scale

    d = D_MODEL
    return {
        'x': nrm((BATCH, SEQ, d), 1.0),
        'c': nrm((BATCH, d), 1.0),
        'ctx': nrm((BATCH, CTX_LEN, d), 1.0),
        'c_ctx': nrm((d,), 1.0),
        'ada_w': nrm((DEPTH, d, 3 * d), d ** -0.5),
        'ada_b': nrm((DEPTH, 3 * d), 0.02),
        'ln_g': 1.0 + nrm((DEPTH, d), 0.01),
        'ln_b': nrm((DEPTH, d), 0.01),
        'ev_w_in': nrm((N_EVEN, d, EVEN_IN), d ** -0.5),
        'ev_b_in': nrm((N_EVEN, EVEN_IN), 0.01),
        'da_lambda': nrm((N_EVEN, 4, DA_QK), 0.1),
        'da_subln_g': 1.0 + nrm((N_EVEN, DA_V), 0.01),
        'mla_q_norm_g': 1.0 + nrm((N_EVEN, MLA_Q_RANK), 0.01),
        'mla_kv_norm_g': 1.0 + nrm((N_EVEN, MLA_KV_RANK), 0.01),
        'mla_w_uq': nrm((N_EVEN, MLA_Q_RANK, MLA_HEADS * (MLA_NOPE + MLA_ROPE)), MLA_Q_RANK ** -0.5),
        'mla_w_ukv': nrm((N_EVEN, MLA_KV_RANK, MLA_HEADS * (MLA_NOPE + MLA_V)), MLA_KV_RANK ** -0.5),
        'ev_w_out': nrm((N_EVEN, EVEN_WIDTH, d), EVEN_WIDTH ** -0.5 * DEEPNORM_BETA),
        'od_w_in': nrm((N_ODD, d, ODD_IN), d ** -0.5),
        'od_b_in': nrm((N_ODD, ODD_IN), 0.01),
        'ml_conv_w': nrm((N_ODD, ML_CONV, 2 * ML_WIDTH), ML_CONV ** -0.5),
        'ml_conv_b': nrm((N_ODD, 2 * ML_WIDTH), 0.01),
        'ml_f_bias': jnp.linspace(3.0, 6.0, ML_HEADS, dtype=F32) + nrm((N_ODD, 2, ML_HEADS), 0.01),
        'ml_norm_g': 1.0 + nrm((N_ODD, ML_WIDTH), 0.01),
        'na_rpb': nrm((N_ODD, NA_HEADS, 2 * NA_ROWS - 1, 2 * NA_COLS - 1), 0.02),
        'od_w_out': nrm((N_ODD, ODD_WIDTH, d), ODD_WIDTH ** -0.5 * DEEPNORM_BETA),
    }


def reference(x, c, ctx, c_ctx, ada_w, ada_b, ln_g, ln_b, ev_w_in, ev_b_in, da_lambda, da_subln_g,
              mla_q_norm_g, mla_kv_norm_g, mla_w_uq, mla_w_ukv, ev_w_out, od_w_in, od_b_in,
              ml_conv_w, ml_conv_b, ml_f_bias, ml_norm_g, na_rpb, od_w_out):
    n_lat = x.shape[1]
    rows = n_lat // GRID_W
    rope_da = axial_rope(n_lat, DA_QK)
    rope_mla = axial_rope(n_lat, MLA_ROPE)
    xl, xc = x, ctx
    for l in range(DEPTH):
        update_ctx = l < DEPTH - 1
        sh_l, sc_l, g_l = adaln(c, ada_w[l], ada_b[l])
        sh_c, sc_c, g_c = adaln(c_ctx, ada_w[l], ada_b[l])
        hl = xl * (1.0 + sc_l[:, None]) + sh_l[:, None]
        hc = xc * (1.0 + sc_c) + sh_c
        i = l // 2
        yc = None
        if l % 2 == 0:
            lam_init = 0.8 - 0.6 * math.exp(-0.3 * l)
            lq1, lk1, lq2, lk2 = da_lambda[i].astype(F32)
            lam = jnp.exp(jnp.sum(lq1 * lk1)) - jnp.exp(jnp.sum(lq2 * lk2)) + lam_init
            ql, kl = even_project(hl, ev_w_in[i], ev_b_in[i], mla_q_norm_g[i], mla_kv_norm_g[i],
                                  mla_w_uq[i], mla_w_ukv[i], rope_da, rope_mla)
            qc, kc = even_project(hc, ev_w_in[i], ev_b_in[i], mla_q_norm_g[i], mla_kv_norm_g[i],
                                  mla_w_uq[i], mla_w_ukv[i], None, None)
            keys_l = tuple(jnp.concatenate([a, b_], axis=2) for a, b_ in zip(kl, kc))
            yl = even_mix(ql, keys_l, lam, lam_init, da_subln_g[i], ev_w_out[i])
            if update_ctx:
                yc = even_mix(qc, kc, lam, lam_init, da_subln_g[i], ev_w_out[i])
        else:
            ml_l, na_l, gate_l = odd_project(hl, od_w_in[i], od_b_in[i], ml_conv_w[i], ml_conv_b[i], ml_f_bias[i])
            ml_c, na_c, gate_c = odd_project(hc, od_w_in[i], od_b_in[i], ml_conv_w[i], ml_conv_b[i], ml_f_bias[i])
            z0 = zero_state(xc.shape[0])
            h_c, st_f, st_b = mlstm_bidirectional(ml_c, z0, z0, update_ctx)
            h_l, _, _ = mlstm_bidirectional(ml_l, st_f, st_b)
            na_out_l = neighbourhood_attention(na_l[0], na_l[1], na_l[2], na_c[1], na_c[2], na_rpb[i], rows)
            yl = odd_mix(h_l, ml_l[3], na_out_l, gate_l, ml_norm_g[i], od_w_out[i])
            if update_ctx:
                qn, kn, vn = (t.transpose(0, 2, 1, 3) for t in na_c)
                na_out_c = softmax_attention(qn, kn, vn, NA_SCALE).transpose(0, 2, 1, 3)
                yc = odd_mix(h_c, ml_c[3], na_out_c, gate_c, ml_norm_g[i], od_w_out[i])
        xl = layer_norm(DEEPNORM_ALPHA * xl + g_l[:, None] * yl, ln_g[l], ln_b[l])
        if update_ctx:
            xc = layer_norm(DEEPNORM_ALPHA * xc + g_c * yc, ln_g[l], ln_b[l])
    return xl
```

```cpp
#include <hip/hip_runtime.h>
#include <hip/hip_cooperative_groups.h>
#include <cstdio>
namespace cg = cooperative_groups;

typedef _Float16 h16;
typedef __attribute__((ext_vector_type(8))) _Float16 h8;
typedef __attribute__((ext_vector_type(4))) _Float16 h4;
typedef __attribute__((ext_vector_type(16))) float f16v;
#define MFMA(a, b, c) __builtin_amdgcn_mfma_f32_32x32x16_f16((a), (b), (c), 0, 0, 0)
#define DI __device__ __forceinline__

constexpr int NB = 4, SEQ = 8192, CTXL = 256, TB = 8448, NR = NB * TB, DM = 1024;
constexpr int EV_IN = 2976, EV_INP = 3072, OD_IN = 4624, OD_INP = 4864;
constexpr int NCHAIN = 32, NCHUNK = 66;
constexpr float LOG2E = 1.4426950408889634f;
constexpr float DN_ALPHA = 1.681792830507429f;

constexpr size_t al256(size_t x) { return (x + 255) & ~(size_t)255; }
constexpr size_t OFF_WEV = 0;
constexpr size_t OFF_WOD = OFF_WEV + al256(2ull * EV_INP * 1024 * 2);
constexpr size_t OFF_WOUT = OFF_WOD + al256(2ull * OD_INP * 1024 * 2);
constexpr size_t OFF_WUQ = OFF_WOUT + al256(4ull * 1024 * 1024 * 2);
constexpr size_t OFF_WUKV = OFF_WUQ + al256(2ull * 768 * 256 * 2);
constexpr size_t OFF_MOD = OFF_WUKV + al256(2ull * 1024 * 128 * 2);
constexpr size_t OFF_RDA = OFF_MOD + al256(4ull * 5 * 3072 * 4);
constexpr size_t OFF_RML = OFF_RDA + al256(8192ull * 32 * 2 * 4);
constexpr size_t OFF_BT = OFF_RML + al256(8192ull * 16 * 2 * 4);
constexpr size_t OFF_GM = OFF_BT + al256(NCHAIN * NCHUNK * 4);
constexpr size_t OFF_MP = OFF_GM + al256(NCHAIN * NCHUNK * 4);
constexpr size_t OFF_NL = OFF_MP + al256(NCHAIN * NCHUNK * 4);
constexpr size_t OFF_BAR = OFF_NL + al256((size_t)NCHAIN * NCHUNK * 128 * 4);
constexpr size_t OFF_X16 = OFF_BAR + 16384;
constexpr size_t SZ_ACT = (size_t)NR * 1024 * 2;
constexpr size_t OFF_GY = OFF_X16 + SZ_ACT;
constexpr size_t OFF_H = OFF_GY + SZ_ACT;
constexpr size_t OFF_SCR = OFF_H + SZ_ACT;
constexpr size_t OFF_T = OFF_SCR;
constexpr size_t OFF_QK4 = OFF_SCR;
constexpr size_t OFF_VT = OFF_QK4 + SZ_ACT;
constexpr size_t OFF_CQKV = OFF_VT + (size_t)NB * 512 * TB * 2;
constexpr size_t OFF_KR = OFF_CQKV + (size_t)NR * 384 * 2;
constexpr size_t OFF_QM = OFF_KR + (size_t)NR * 32 * 2;
constexpr size_t OFF_KN = OFF_QM + (size_t)NR * 768 * 2;
constexpr size_t OFF_VMT = OFF_KN + (size_t)NR * 512 * 2;
constexpr size_t END_EVEN = OFF_VMT + (size_t)NB * 512 * TB * 2;
constexpr size_t OFF_QKP = OFF_SCR;
constexpr size_t OFF_MVT = OFF_QKP + SZ_ACT;
constexpr size_t OFF_OG = OFF_MVT + (size_t)NB * 512 * TB * 2;
constexpr size_t OFF_NAQ = OFF_OG + (size_t)NR * 512 * 2;
constexpr size_t OFF_NAK = OFF_NAQ + (size_t)NR * 512 * 2;
constexpr size_t OFF_NAVT = OFF_NAK + (size_t)NR * 512 * 2;
constexpr size_t OFF_GT = OFF_NAVT + (size_t)NB * 512 * TB * 2;
constexpr size_t END_ODD = OFF_GT + (size_t)NR * 16 * 4;
constexpr size_t WS_NEED = END_EVEN > END_ODD ? END_EVEN : END_ODD;
static_assert(WS_NEED <= 536870912ull, "workspace too big");
static_assert(OFF_QKP + SZ_ACT + 2 * (size_t)NB * 512 * TB * 2 >= OFF_T + (size_t)NR * 1024 * 4, "T alias odd");

#ifndef NREP_GEMM
#define NREP_GEMM 1
#endif
struct Params {
  const float *x, *c, *ctx, *c_ctx, *ada_w, *ada_b, *ln_g, *ln_b, *ev_w_in, *ev_b_in, *da_lambda, *da_subln_g,
      *mla_q_norm_g, *mla_kv_norm_g, *mla_w_uq, *mla_w_ukv, *ev_w_out, *od_w_in, *od_b_in, *ml_conv_w, *ml_conv_b,
      *ml_f_bias, *ml_norm_g, *na_rpb, *od_w_out;
  float* out;
  char* ws;
};

DI int crow(int i, int hh) { return (i & 3) + 8 * (i >> 2) + 4 * hh; }
DI float silu_f(float v) { return v / (1.f + __expf(-v)); }
DI float sigmoid_f(float v) { return 1.f / (1.f + __expf(-v)); }
DI float logsig_f(float v) { return fminf(v, 0.f) - log1pf(__expf(-fabsf(v))); }
DI float xhalf_max(float x) {
  const unsigned u = __float_as_uint(x);
  auto rr = __builtin_amdgcn_permlane32_swap(u, u, false, false);
  return fmaxf(__uint_as_float(rr[0]), __uint_as_float(rr[1]));
}
DI float xhalf_sum(float x) {
  const unsigned u = __float_as_uint(x);
  auto rr = __builtin_amdgcn_permlane32_swap(u, u, false, false);
  return __uint_as_float(rr[0]) + __uint_as_float(rr[1]);
}
DI h8 cat44(h4 a, h4 b) { return __builtin_shufflevector(a, b, 0, 1, 2, 3, 4, 5, 6, 7); }
DI f16v zero16() { f16v z;
#pragma unroll
  for (int i = 0; i < 16; ++i) z[i] = 0.f; return z; }

DI const float* in_row(const Params& p, int R) {
  int b = R / TB, j = R - b * TB;
  return j < SEQ ? p.x + ((size_t)b * SEQ + j) * DM : p.ctx + ((size_t)b * CTXL + (j - SEQ)) * DM;
}

template <class Epi>
DI void gemm_tile(const h16* __restrict__ A, int lda, const h16* __restrict__ Bt, int ldb, int K, int row0, int col0,
                  char* smem, const Epi& epi) {
  h16* As = (h16*)smem;
  h16* Bs = As + 128 * 72;
  int tid = threadIdx.x; asm volatile("" : "+v"(tid));
  const int lane = tid & 63, w = tid >> 6, wm = w >> 1, wn = w & 1, r = lane & 31, hh = lane >> 5;
  f16v acc00 = zero16(), acc01 = zero16(), acc10 = zero16(), acc11 = zero16();
  const int lr = tid >> 3, lc = (tid & 7) * 8;
  const h16* Ap = A + (size_t)(row0 + lr) * lda + lc;
  const h16* Bp = Bt + (size_t)(col0 + lr) * ldb + lc;
  const size_t sa = (size_t)32 * lda, sb = (size_t)32 * ldb;
  uint4 ra0, ra1, ra2, ra3, rb0, rb1, rb2, rb3;
  uint4 sa0, sa1, sa2, sa3, sb0, sb1, sb2, sb3;
#define GLOAD(K0)                                                                                   \
  ra0 = *(const uint4*)(Ap + (K0)); ra1 = *(const uint4*)(Ap + sa + (K0));                          \
  ra2 = *(const uint4*)(Ap + 2 * sa + (K0)); ra3 = *(const uint4*)(Ap + 3 * sa + (K0));             \
  rb0 = *(const uint4*)(Bp + (K0)); rb1 = *(const uint4*)(Bp + sb + (K0));                          \
  rb2 = *(const uint4*)(Bp + 2 * sb + (K0)); rb3 = *(const uint4*)(Bp + 3 * sb + (K0));
#define GLOADB(K0)                                                                                  \
  sa0 = *(const uint4*)(Ap + (K0)); sa1 = *(const uint4*)(Ap + sa + (K0));                          \
  sa2 = *(const uint4*)(Ap + 2 * sa + (K0)); sa3 = *(const uint4*)(Ap + 3 * sa + (K0));             \
  sb0 = *(const uint4*)(Bp + (K0)); sb1 = *(const uint4*)(Bp + sb + (K0));                          \
  sb2 = *(const uint4*)(Bp + 2 * sb + (K0)); sb3 = *(const uint4*)(Bp + 3 * sb + (K0));
#define SWRITE(ST)                                                                                  \
  { h16* as_ = As + (ST) * 18432 + lr * 72 + lc; h16* bs_ = Bs + (ST) * 18432 + lr * 72 + lc;       \
  *(uint4*)(as_) = ra0; *(uint4*)(as_ + 32 * 72) = ra1;                                             \
  *(uint4*)(as_ + 64 * 72) = ra2; *(uint4*)(as_ + 96 * 72) = ra3;                                   \
  *(uint4*)(bs_) = rb0; *(uint4*)(bs_ + 32 * 72) = rb1;                                             \
  *(uint4*)(bs_ + 64 * 72) = rb2; *(uint4*)(bs_ + 96 * 72) = rb3; }
#define SWRITEB(ST)                                                                                 \
  { h16* as_ = As + (ST) * 18432 + lr * 72 + lc; h16* bs_ = Bs + (ST) * 18432 + lr * 72 + lc;       \
  *(uint4*)(as_) = sa0; *(uint4*)(as_ + 32 * 72) = sa1;                                             \
  *(uint4*)(as_ + 64 * 72) = sa2; *(uint4*)(as_ + 96 * 72) = sa3;                                   \
  *(uint4*)(bs_) = sb0; *(uint4*)(bs_ + 32 * 72) = sb1;                                             \
  *(uint4*)(bs_ + 64 * 72) = sb2; *(uint4*)(bs_ + 96 * 72) = sb3; }
#define GCOMPUTE(ST)                                                                                \
  { const h16* Ac = As + (ST) * 18432; const h16* Bc = Bs + (ST) * 18432;                           \
    _Pragma("unroll") for (int kk = 0; kk < 4; ++kk) {                                              \
      h8 a0 = *(const h8*)(Ac + (wm * 64 + r) * 72 + kk * 16 + hh * 8);                             \
      h8 a1 = *(const h8*)(Ac + (wm * 64 + 32 + r) * 72 + kk * 16 + hh * 8);                        \
      h8 b0 = *(const h8*)(Bc + (wn * 64 + r) * 72 + kk * 16 + hh * 8);                             \
      h8 b1 = *(const h8*)(Bc + (wn * 64 + 32 + r) * 72 + kk * 16 + hh * 8);                        \
      acc00 = MFMA(a0, b0, acc00); acc01 = MFMA(a0, b1, acc01);                                     \
      acc10 = MFMA(a1, b0, acc10); acc11 = MFMA(a1, b1, acc11); } }
  GLOAD(0)
  SWRITE(0)
  __syncthreads();
  GLOAD(64)
  if (128 < K) { GLOADB(128) }
#pragma unroll 1
  for (int k0 = 0; k0 < K; k0 += 128) {
    SWRITE(1)
    if (k0 + 192 < K) { GLOAD(k0 + 192) }
    GCOMPUTE(0)
    __syncthreads();
    if (k0 + 128 < K) {
      SWRITEB(0)
      if (k0 + 256 < K) { GLOADB(k0 + 256) }
    }
    GCOMPUTE(1)
    __syncthreads();
  }
#undef GLOADB
#undef SWRITEB
#undef GCOMPUTE
#undef GLOAD
#undef SWRITE
  epi.frag(smem, row0 + wm * 64, col0 + wn * 64, wm * 64, wn * 64, acc00, acc01);
  epi.frag(smem, row0 + wm * 64 + 32, col0 + wn * 64, wm * 64 + 32, wn * 64, acc10, acc11);
  __syncthreads();
  epi.copy(smem, row0, col0);
  __syncthreads();
}

constexpr int STG_T_OFF = 34816;
template <class Epi>
DI void gemm_tile_w(const h16* __restrict__ A, int lda, const h16* __restrict__ Bt, int ldb, int K, int row0, int col0,
                    char* smem, const Epi& epi) {
  h16* As = (h16*)smem;
  h16* Bs = As + 128 * 40;
  int tid = threadIdx.x; asm volatile("" : "+v"(tid));
  const int lane = tid & 63, w = tid >> 6, wm = w >> 1, wn = w & 1, r = lane & 31, hh = lane >> 5;
  f16v acc[2][4];
#pragma unroll
  for (int i = 0; i < 2; ++i)
#pragma unroll
    for (int j = 0; j < 4; ++j) acc[i][j] = zero16();
  const int lr = tid >> 2, lc = (tid & 3) * 8;
  const h16* Ap = A + (size_t)(row0 + lr) * lda + lc;
  const h16* Bp = Bt + (size_t)(col0 + lr) * ldb + lc;
  const size_t sa = (size_t)64 * lda, sb = (size_t)64 * ldb;
  uint4 ra0, ra1, rb0, rb1, rb2, rb3;
#define WLOAD(K0) ra0 = *(const uint4*)(Ap + (K0)); ra1 = *(const uint4*)(Ap + sa + (K0));                       \
  rb0 = *(const uint4*)(Bp + (K0)); rb1 = *(const uint4*)(Bp + sb + (K0));                                        \
  rb2 = *(const uint4*)(Bp + 2 * sb + (K0)); rb3 = *(const uint4*)(Bp + 3 * sb + (K0));
#define WWRITE(ST) { h16* as_ = As + (ST) * 15360 + lr * 40 + lc; h16* bs_ = Bs + (ST) * 15360 + lr * 40 + lc;   \
  *(uint4*)(as_) = ra0; *(uint4*)(as_ + 64 * 40) = ra1;                                                           \
  *(uint4*)(bs_) = rb0; *(uint4*)(bs_ + 64 * 40) = rb1; *(uint4*)(bs_ + 128 * 40) = rb2; *(uint4*)(bs_ + 192 * 40) = rb3; }
  WLOAD(0)
  WWRITE(0)
  __syncthreads();
  WLOAD(32)
#pragma unroll 1
  for (int k0 = 0; k0 < K; k0 += 32) {
    const int st = (k0 >> 5) & 1;
    if (k0 + 32 < K) {
      WWRITE(st ^ 1)
      if (k0 + 64 < K) { WLOAD(k0 + 64) }
    }
    const h16* Ac = As + st * 15360 + (wm * 64 + r) * 40 + hh * 8;
    const h16* Bc = Bs + st * 15360 + (wn * 128 + r) * 40 + hh * 8;
#pragma unroll
    for (int kk = 0; kk < 2; ++kk) {
      const h8 a0 = *(const h8*)(Ac + kk * 16), a1 = *(const h8*)(Ac + 32 * 40 + kk * 16);
      const h8 b0 = *(const h8*)(Bc + kk * 16), b1 = *(const h8*)(Bc + 32 * 40 + kk * 16);
      const h8 b2 = *(const h8*)(Bc + 64 * 40 + kk * 16), b3 = *(const h8*)(Bc + 96 * 40 + kk * 16);
      acc[0][0] = MFMA(a0, b0, acc[0][0]); acc[0][1] = MFMA(a0, b1, acc[0][1]);
      acc[0][2] = MFMA(a0, b2, acc[0][2]); acc[0][3] = MFMA(a0, b3, acc[0][3]);
      acc[1][0] = MFMA(a1, b0, acc[1][0]); acc[1][1] = MFMA(a1, b1, acc[1][1]);
      acc[1][2] = MFMA(a1, b2, acc[1][2]); acc[1][3] = MFMA(a1, b3, acc[1][3]);
    }
    __syncthreads();
  }
#undef WLOAD
#undef WWRITE
  if (!epi.has_tr(col0)) {
    char* sm = smem + wn * STG_T_OFF;
#pragma unroll
    for (int mi = 0; mi < 2; ++mi) {
      epi.frag(sm, row0 + wm * 64 + mi * 32, col0 + wn * 128, wm * 64 + mi * 32, 0, acc[mi][0], acc[mi][1]);
      epi.frag(sm, row0 + wm * 64 + mi * 32, col0 + wn * 128 + 64, wm * 64 + mi * 32, 64, acc[mi][2], acc[mi][3]);
    }
    __syncthreads();
    epi.copy(smem, row0, col0);
    epi.copy(smem + STG_T_OFF, row0, col0 + 128);
    __syncthreads();
    return;
  }
#pragma unroll
  for (int h = 0; h < 2; ++h) {
    if (wn == h) {
#pragma unroll
      for (int mi = 0; mi < 2; ++mi) {
        epi.frag(smem, row0 + wm * 64 + mi * 32, col0 + h * 128, wm * 64 + mi * 32, 0, acc[mi][0], acc[mi][1]);
        epi.frag(smem, row0 + wm * 64 + mi * 32, col0 + h * 128 + 64, wm * 64 + mi * 32, 64, acc[mi][2], acc[mi][3]);
      }
    }
    __syncthreads();
    epi.copy(smem, row0, col0 + h * 128);
    __syncthreads();
  }
}

DI void store_tr(h16* base, const f16v& cc, float bv, int hh) {
#pragma unroll
  for (int g = 0; g < 4; ++g) {
    h4 v;
#pragma unroll
    for (int e = 0; e < 4; ++e) v[e] = (h16)(cc[4 * g + e] + bv);
    *(h4*)(base + 16 * (g >> 1) + 8 * hh + 4 * (g & 1)) = v;
  }
}

DI int perm16pos(int t) { return (t & ~15) | ((t & 3) | ((t & 4) << 1) | ((t & 8) >> 1)); }
DI void stage_tr(h16* stT, int cl, int rlw, int hh, const f16v& cc, float bv) {
#pragma unroll
  for (int g = 0; g < 4; ++g) {
    h4 v;
#pragma unroll
    for (int e = 0; e < 4; ++e) v[e] = (h16)(cc[4 * g + e] + bv);
    *(h4*)(stT + cl * 136 + rlw + 16 * (g >> 1) + 8 * hh + 4 * (g & 1)) = v;
  }
}
template <class F>
DI void copy_tr(const h16* stT, int tid, F dstf) {
#pragma unroll 1
  for (int c = tid; c < 2048; c += 256) {
    const int cl = c >> 4, g8 = c & 15;
    h16* d = dstf(cl);
    if (d) *(uint4*)(d + g8 * 8) = *(const uint4*)(stT + cl * 136 + g8 * 8);
  }
}

struct EpiEven {
  const float* bias; const float* rda; const float* rml;
  h16 *QK4, *VT, *CQKV, *KR, *G;
  DI bool has_tr(int col0) const { return col0 + 256 > 1024 && col0 < 1536; }
  DI void frag(char* smem, int row0, int col0, int rlw, int clw, const f16v& c0, const f16v& c1) const {
    int tid_ = threadIdx.x; asm volatile("" : "+v"(tid_));
    const int lane = tid_ & 63, r = lane & 31, hh = lane >> 5;
    h16* stN = (h16*)smem;
    h16* stT = (h16*)(smem + STG_T_OFF);
    const int b = row0 / TB, jb = row0 - b * TB;
    const bool lat = jb < SEQ;
    if (col0 < 1024) {
      const int ca = col0 + r, cb2 = ca + 32;
      const float ba = bias[ca], bb = bias[cb2];
      const float qs = col0 < 512 ? 0.125f * LOG2E : 1.0f;
#pragma unroll
      for (int i = 0; i < 16; ++i) {
        const int rr = crow(i, hh);
        float v1 = c0[i] + ba, v2 = c1[i] + bb, o1 = v1, o2 = v2;
        if (lat) {
          const float2 cs = *(const float2*)(rda + ((size_t)(jb + rr) * 32 + r) * 2);
          o1 = v1 * cs.x - v2 * cs.y;
          o2 = v2 * cs.x + v1 * cs.y;
        }
        stN[(rlw + rr) * 136 + clw + r] = (h16)(o1 * qs);
        stN[(rlw + rr) * 136 + clw + 32 + r] = (h16)(o2 * qs);
        if ((i & 3) == 3) __builtin_amdgcn_sched_barrier(0);
      }
      return;
    }
#pragma unroll
    for (int half = 0; half < 2; ++half) {
      const int cb = col0 + 32 * half;
      if (cb >= EV_IN) continue;
      const f16v& cc = half ? c1 : c0;
      const int col = cb + r, cl = clw + 32 * half + r;
      const float bv = bias[col];
      if (cb < 1536) {
        stage_tr(stT, cl, rlw, hh, cc, bv);
      } else if (cb < 1920) {
#pragma unroll
        for (int i = 0; i < 16; ++i) stN[(rlw + crow(i, hh)) * 136 + cl] = (h16)(cc[i] + bv);
      } else if (cb == 1920) {
#pragma unroll
        for (int i = 0; i < 16; ++i) {
          const int rr = crow(i, hh);
          float v = cc[i] + bv;
          float pv = __shfl_xor(v, 16);
          float o = v;
          if (lat) {
            const float2 cs = *(const float2*)(rml + ((size_t)(jb + rr) * 16 + (r & 15)) * 2);
            o = (r < 16) ? (v * cs.x - pv * cs.y) : (v * cs.x + pv * cs.y);
          }
          stN[(rlw + rr) * 136 + cl] = (h16)o;
          __builtin_amdgcn_sched_barrier(0);
        }
      } else {
#pragma unroll
        for (int i = 0; i < 16; ++i) stN[(rlw + crow(i, hh)) * 136 + cl] = (h16)silu_f(cc[i] + bv);
      }
    }
  }
  DI void copy(char* smem, int row0, int col0) const {
    int tid = threadIdx.x; asm volatile("" : "+v"(tid));
    const h16* stN = (const h16*)smem;
    const h16* stT = (const h16*)(smem + STG_T_OFF);
    const int b = row0 / TB, jb = row0 - b * TB;
    if (col0 >= 1024 && col0 < 1536) {
      h16* base = VT + ((size_t)b * 512 + (col0 - 1024)) * TB + jb;
      copy_tr(stT, tid, [&](int cl) { return base + (size_t)cl * TB; });
      return;
    }
#pragma unroll 1
    for (int c = tid; c < 2048; c += 256) {
      const int rl = c >> 4, c8 = (c & 15) * 8, col = col0 + c8;
      const size_t row = (size_t)row0 + rl;
      h16* d;
      if (col < 1024) d = QK4 + row * 1024 + col;
      else if (col < 1920) d = CQKV + row * 384 + (col - 1536);
      else if (col < 1952) d = KR + row * 32 + (col - 1920);
      else if (col < EV_IN) d = G + row * 1024 + (col - 1952);
      else continue;
      *(uint4*)d = *(const uint4*)(stN + rl * 136 + c8);
    }
  }
};

struct EpiUQ {
  const float* rstd; int tile_row0; const float* rml; h16* QM;
  DI void frag(char* smem, int row0, int col0, int rlw, int clw, const f16v& c0, const f16v& c1) const {
    int tid_ = threadIdx.x; asm volatile("" : "+v"(tid_));
    const int lane = tid_ & 63, r = lane & 31, hh = lane >> 5;
    h16* stN = (h16*)smem;
    const int b = row0 / TB, jb = row0 - b * TB;
    const bool lat = jb < SEQ;
#pragma unroll
    for (int half = 0; half < 2; ++half) {
      const int cb = col0 + 32 * half;
      const f16v& cc = half ? c1 : c0;
      const bool rope = (cb % 96) == 64;
#pragma unroll
      for (int i = 0; i < 16; ++i) {
        const int rr = crow(i, hh);
        float v = cc[i] * rstd[rlw + rr];
        float pv = __shfl_xor(v, 16);
        float o = v;
        if (rope && lat) {
          const float2 cs = *(const float2*)(rml + ((size_t)(jb + rr) * 16 + (r & 15)) * 2);
          o = (r < 16) ? (v * cs.x - pv * cs.y) : (v * cs.x + pv * cs.y);
        }
        stN[(rlw + rr) * 136 + clw + 32 * half + r] = (h16)(o * (0.10206207261596575f * LOG2E));
        if ((i & 3) == 3) __builtin_amdgcn_sched_barrier(0);
      }
    }
  }
  DI void copy(char* smem, int row0, int col0) const {
    int tid = threadIdx.x; asm volatile("" : "+v"(tid));
    const h16* stN = (const h16*)smem;
#pragma unroll 1
    for (int c = tid; c < 2048; c += 256) {
      const int rl = c >> 4, c8 = (c & 15) * 8;
      *(uint4*)(QM + ((size_t)row0 + rl) * 768 + col0 + c8) = *(const uint4*)(stN + rl * 136 + c8);
    }
  }
};

struct EpiUKV {
  const float* rstd; int tile_row0; h16 *KN, *VMT;
  DI void frag(char* smem, int row0, int col0, int rlw, int clw, const f16v& c0, const f16v& c1) const {
    int tid_ = threadIdx.x; asm volatile("" : "+v"(tid_));
    const int lane = tid_ & 63, r = lane & 31, hh = lane >> 5;
    h16* stN = (h16*)smem;
    h16* stT = (h16*)(smem + STG_T_OFF);
    const bool isv = (col0 & 64) != 0;
#pragma unroll
    for (int half = 0; half < 2; ++half) {
      const f16v& cc = half ? c1 : c0;
      const int cl = clw + 32 * half + r;
      if (!isv) {
#pragma unroll
        for (int i = 0; i < 16; ++i) {
          const int rr = crow(i, hh);
          stN[(rlw + rr) * 136 + cl] = (h16)(cc[i] * rstd[rlw + rr]);
        }
      } else {
#pragma unroll
        for (int g = 0; g < 4; ++g) {
          h4 v;
#pragma unroll
          for (int e = 0; e < 4; ++e) v[e] = (h16)(cc[4 * g + e] * rstd[rlw + 8 * g + 4 * hh + e]);
          *(h4*)(stT + cl * 136 + rlw + 16 * (g >> 1) + 8 * hh + 4 * (g & 1)) = v;
        }
      }
    }
  }
  DI void copy(char* smem, int row0, int col0) const {
    int tid = threadIdx.x; asm volatile("" : "+v"(tid));
    const h16* stN = (const h16*)smem;
    const h16* stT = (const h16*)(smem + STG_T_OFF);
    const int b = row0 / TB, jb = row0 - b * TB;
    const int head = col0 >> 7;
#pragma unroll 1
    for (int c = tid; c < 1024; c += 256) {
      const int rl = c >> 3, c8 = (c & 7) * 8;
      *(uint4*)(KN + ((size_t)row0 + rl) * 512 + head * 64 + c8) = *(const uint4*)(stN + rl * 136 + c8);
    }
    h16* base = VMT + ((size_t)b * 512 + head * 64) * TB + jb;
    copy_tr(stT, tid, [&](int cl) -> h16* { return cl >= 64 ? base + (size_t)(cl - 64) * TB : (h16*)nullptr; });
  }
};

struct EpiOut {
  const float* xin; const float* cin; int layer; const float* mod; const h16* X16; h16* T;
  DI void frag(char* smem, int row0, int col0, int rlw, int clw, const f16v& c0, const f16v& c1) const {
    int tid_ = threadIdx.x; asm volatile("" : "+v"(tid_));
    const int lane = tid_ & 63, r = lane & 31, hh = lane >> 5;
    float* st = (float*)smem;
#pragma unroll
    for (int i = 0; i < 16; ++i) {
      st[(rlw + crow(i, hh)) * 132 + clw + r] = c0[i];
      st[(rlw + crow(i, hh)) * 132 + clw + 32 + r] = c1[i];
    }
  }
  DI void copy(char* smem, int row0, int col0) const {
    int tid = threadIdx.x; asm volatile("" : "+v"(tid));
    const float* st = (const float*)smem;
    const int b = row0 / TB, jb = row0 - b * TB;
    const int mr = jb < SEQ ? b : 4;
    const float* gp = mod + ((size_t)layer * 5 + mr) * 3072 + 2048;
#pragma unroll 1
    for (int c = tid; c < 4096; c += 256) {
      const int rl = c >> 5, c4 = (c & 31) * 4, col = col0 + c4;
      const size_t R = (size_t)row0 + rl;
      const float4 a = *(const float4*)(st + rl * 132 + c4);
      const float4 g = *(const float4*)(gp + col);
      float4 xv;
      if (layer == 0) {
        const int jj = jb + rl;
        const float* xp = jj < SEQ ? xin + ((size_t)b * SEQ + jj) * DM + col : cin + ((size_t)b * CTXL + (jj - SEQ)) * DM + col;
        xv = *(const float4*)xp;
      } else {
        const h4 xh = *(const h4*)(X16 + R * 1024 + col);
        xv.x = (float)xh[0]; xv.y = (float)xh[1]; xv.z = (float)xh[2]; xv.w = (float)xh[3];
      }
      float4 o;
      o.x = DN_ALPHA * xv.x + g.x * a.x; o.y = DN_ALPHA * xv.y + g.y * a.y;
      o.z = DN_ALPHA * xv.z + g.z * a.z; o.w = DN_ALPHA * xv.w + g.w * a.w;
      h4 oh; oh[0] = (h16)o.x; oh[1] = (h16)o.y; oh[2] = (h16)o.z; oh[3] = (h16)o.w;
      *(h4*)(T + R * 1024 + col) = oh;
    }
  }
};

struct EpiOdd {
  const float* bias; h16 *QKP, *MVT, *OG, *NAQ, *NAK, *NAVT, *G; float* GT;
  DI bool has_tr(int col0) const { return (col0 + 256 > 1024 && col0 < 1536) || (col0 + 256 > 3088 && col0 < 3600); }
  DI void frag(char* smem, int row0, int col0, int rlw, int clw, const f16v& c0, const f16v& c1) const {
    int tid_ = threadIdx.x; asm volatile("" : "+v"(tid_));
    const int lane = tid_ & 63, r = lane & 31, hh = lane >> 5;
    h16* stN = (h16*)smem;
    h16* stT = (h16*)(smem + STG_T_OFF);
#pragma unroll
    for (int half = 0; half < 2; ++half) {
      const f16v& cc = half ? c1 : c0;
      const int col = col0 + 32 * half + r, cl = clw + 32 * half + r;
      if (col >= OD_IN) continue;
      const float bv = bias[col];
      const bool tr = (col >= 1024 && col < 1536) || (col >= 3088 && col < 3600);
      if (tr) {
        stage_tr(stT, cl, rlw, hh, cc, bv);
      } else if (col >= 2048 && col < 2064) {
#pragma unroll
        for (int i = 0; i < 16; ++i) GT[(size_t)(row0 + crow(i, hh)) * 16 + (col - 2048)] = cc[i] + bv;
      } else if (col >= 1536 && col < 2048) {
#pragma unroll
        for (int i = 0; i < 16; ++i) stN[(rlw + crow(i, hh)) * 136 + cl] = (h16)sigmoid_f(cc[i] + bv);
      } else if (col >= 3600) {
#pragma unroll
        for (int i = 0; i < 16; ++i) stN[(rlw + crow(i, hh)) * 136 + cl] = (h16)silu_f(cc[i] + bv);
      } else {
#pragma unroll
        for (int i = 0; i < 16; ++i) stN[(rlw + crow(i, hh)) * 136 + cl] = (h16)(cc[i] + bv);
      }
    }
  }
  DI void copy(char* smem, int row0, int col0) const {
    int tid = threadIdx.x; asm volatile("" : "+v"(tid));
    const h16* stN = (const h16*)smem;
    const h16* stT = (const h16*)(smem + STG_T_OFF);
    const int b = row0 / TB, jb = row0 - b * TB;
#pragma unroll 1
    for (int c = tid; c < 2048; c += 256) {
      const int rl = c >> 4, c8 = (c & 15) * 8, col = col0 + c8;
      const size_t row = (size_t)row0 + rl;
      h16* d;
      if (col < 1024) d = QKP + row * 1024 + col;
      else if (col < 1536) continue;
      else if (col < 2048) d = OG + row * 512 + (col - 1536);
      else if (col < 2064) continue;
      else if (col < 2576) d = NAQ + row * 512 + (col - 2064);
      else if (col < 3088) d = NAK + row * 512 + (col - 2576);
      else if (col < 3600) continue;
      else if (col < OD_IN) d = G + row * 1024 + (col - 3600);
      else continue;
      *(uint4*)d = *(const uint4*)(stN + rl * 136 + c8);
    }
    if ((col0 + 128 > 1024 && col0 < 1536) || (col0 + 128 > 3088 && col0 < 3600)) {
      copy_tr(stT, tid, [&](int cl) -> h16* {
        const int col = col0 + cl;
        if (col >= 1024 && col < 1536) return MVT + ((size_t)b * 512 + (col - 1024)) * TB + jb;
        if (col >= 3088 && col < 3600) return NAVT + ((size_t)b * 512 + (col - 3088)) * TB + jb;
        return (h16*)nullptr;
      });
    }
  }
};

DI float softmax_tile(f16v& s, float& m, float& l, float sc, h8& p0, h8& p1) {
  float mx = s[0];
#pragma unroll
  for (int i = 1; i < 16; ++i) mx = fmaxf(mx, s[i]);
  mx = xhalf_max(mx) * sc;
  float mn = m, alpha = 1.0f;
  if (__any(mx > m + 8.0f)) {
    mn = fmaxf(m, mx);
    alpha = __builtin_amdgcn_exp2f(m - mn);
  }
  float sum = 0.f;
#pragma unroll
  for (int i = 0; i < 16; ++i) {
    float pv = __builtin_amdgcn_exp2f(s[i] * sc - mn);
    sum += pv;
    s[i] = pv;
  }
#pragma unroll
  for (int j = 0; j < 8; ++j) { p0[j] = (h16)s[j]; p1[j] = (h16)s[8 + j]; }
  l = l * alpha + sum;
  m = mn;
  return alpha;
}

DI float softmax_shifted(f16v& s, float& m, float& l, h8& qx, bool first, bool lo_half, h8& p0, h8& p1) {
  float sum = 0.f;
#pragma unroll
  for (int i = 0; i < 16; ++i) {
    const float pv = __builtin_amdgcn_exp2f(s[i]);
    sum += pv;
    s[i] = pv;
  }
  float alpha = 1.0f;
  if (__any(sum > 4096.0f) || first) {
    float mx = s[0];
#pragma unroll
    for (int i = 1; i < 16; ++i) mx = fmaxf(mx, s[i]);
    mx = fmaxf(xhalf_max(mx), 1e-30f);
    float d = __builtin_amdgcn_logf(mx);
    if (!first) d = fmaxf(d, 0.f);
    const float mn = (float)(h16)(m + d);
    d = mn - m;
    const float f = __builtin_amdgcn_exp2f(-d);
#pragma unroll
    for (int i = 0; i < 16; ++i) s[i] *= f;
    sum *= f;
    alpha = first ? 1.0f : f;
    m = mn;
    qx[0] = lo_half ? (h16)(-mn) : (h16)0.f;
  }
#pragma unroll
  for (int j = 0; j < 8; ++j) { p0[j] = (h16)s[j]; p1[j] = (h16)s[8 + j]; }
  l = l * alpha + sum;
  return alpha;
}

template <int NMAP, int NKK, int NDVT, class KL, class VL>
DI void flash_wave(const h8 (&qf)[NMAP][NKK], f16v (&O)[NMAP][NDVT], float (&mm)[NMAP], float (&ll)[NMAP], int t0, int t1,
                   float sc, KL kl, VL vl) {
  for (int t = t0; t < t1; ++t) {
    f16v S[NMAP];
    h8 pf[NMAP][2];
    float al[NMAP];
#pragma unroll
    for (int m = 0; m < NMAP; ++m) {
      S[m] = zero16();
#pragma unroll
      for (int kk = 0; kk < NKK; ++kk) S[m] = MFMA(kl(m, kk, t), qf[m][kk], S[m]);
    }
#pragma unroll
    for (int m = 0; m < NMAP; ++m) al[m] = softmax_tile(S[m], mm[m], ll[m], sc, pf[m][0], pf[m][1]);
#pragma unroll
    for (int m = 0; m < NMAP; ++m)
#pragma unroll
      for (int d = 0; d < NDVT; ++d)
#pragma unroll
        for (int i = 0; i < 16; ++i) O[m][d][i] *= al[m];
#pragma unroll
    for (int d = 0; d < NDVT; ++d)
#pragma unroll
      for (int s = 0; s < 2; ++s) {
        h8 vf = vl(d, t, s);
#pragma unroll
        for (int m = 0; m < NMAP; ++m) O[m][d] = MFMA(vf, pf[m][s], O[m][d]);
      }
  }
}

template <int OFF> DI void lds_rd(h8& d, unsigned a) { asm volatile("ds_read_b128 %0, %1 offset:%2" : "=v"(d) : "v"(a), "n"(OFF)); }
#define LGKM_WAIT4(N, a, b, c, d) asm volatile("s_waitcnt lgkmcnt(" #N ")" : "+v"(a), "+v"(b), "+v"(c), "+v"(d))
#define LGKM_WAIT6(N, a, b, c, d, e, f) asm volatile("s_waitcnt lgkmcnt(" #N ")" : "+v"(a), "+v"(b), "+v"(c), "+v"(d), "+v"(e), "+v"(f))
#define LGKM_WAIT8(N, a, b, c, d, e, f, g, h) asm volatile("s_waitcnt lgkmcnt(" #N ")" : "+v"(a), "+v"(b), "+v"(c), "+v"(d), "+v"(e), "+v"(f), "+v"(g), "+v"(h))
#define LGKM_WAIT5(N, a, b, c, d, e) asm volatile("s_waitcnt lgkmcnt(" #N ")" : "+v"(a), "+v"(b), "+v"(c), "+v"(d), "+v"(e))
#define LGKM_WAIT9(N, a, b, c, d, e, f, g, h, i) asm volatile("s_waitcnt lgkmcnt(" #N ")" : "+v"(a), "+v"(b), "+v"(c), "+v"(d), "+v"(e), "+v"(f), "+v"(g), "+v"(h), "+v"(i))

template <int mp>
DI void da_map(const Params& p, int layer, int b, int hd, int qj0, int t0, int t1, float lam, float lam_init, char* smem, int dry) {
  char* ws = p.ws; asm volatile("" : "+s"(ws));
  const h16* QK4 = (const h16*)(ws + OFF_QK4);
  const h16* VT = (const h16*)(ws + OFF_VT);
  h16* AM = (h16*)(ws + OFF_H);
  h16* GY = (h16*)(ws + OFF_GY);
  int tid = threadIdx.x; asm volatile("" : "+v"(tid));
  const int lane = tid & 63, w = tid >> 6, r = lane & 31, hh = lane >> 5;
  const size_t R = (size_t)b * TB + qj0 + w * 32 + r;
  h16* Ks = (h16*)smem;
  h16* Vs = (h16*)(smem + 2 * 9216);
  {
  h8 qf[4];
#pragma unroll
  for (int kk = 0; kk < 4; ++kk) qf[kk] = *(const h8*)(QK4 + R * 1024 + mp * 256 + hd * 64 + kk * 16 + hh * 8);
  const float sc = 0.125f * LOG2E;
  const h16* kg = QK4 + ((size_t)b * TB + (tid >> 3)) * 1024 + 512 + mp * 256 + hd * 64 + (tid & 7) * 8;
  const int kd = (tid >> 3) * 72 + (tid & 7) * 8;
  const h16* vg = VT + ((size_t)b * 512 + hd * 128 + (tid >> 3)) * TB + (tid & 7) * 8;
  const int vd = (tid >> 3) * 72 + (tid & 7) * 8;
  uint4 k0, k1, v0, v1, v2, v3;
#define KLOAD(T) { const h16* s_ = kg + (size_t)(T) * 65536; k0 = *(const uint4*)s_; k1 = *(const uint4*)(s_ + 32768); }
#define KWRITE(ST) { h16* d_ = Ks + (ST) * 4608 + kd; *(uint4*)d_ = k0; *(uint4*)(d_ + 32 * 72) = k1; }
#define VLOAD(T) { const h16* s_ = vg + (T) * 64; v0 = *(const uint4*)s_; v1 = *(const uint4*)(s_ + (size_t)32 * TB); v2 = *(const uint4*)(s_ + (size_t)64 * TB); v3 = *(const uint4*)(s_ + (size_t)96 * TB); }
#define VWRITE(ST) { h16* d_ = Vs + (ST) * 9216 + vd; *(uint4*)d_ = v0; *(uint4*)(d_ + 32 * 72) = v1; *(uint4*)(d_ + 64 * 72) = v2; *(uint4*)(d_ + 96 * 72) = v3; }
  f16v O0 = zero16(), O1 = zero16(), O2 = zero16(), O3 = zero16();
  float m = 0.f, l = 0.f;
  h8 kx, qx;
#pragma unroll
  for (int j = 0; j < 8; ++j) { kx[j] = (h16)0.f; qx[j] = (h16)0.f; }
  kx[0] = hh == 0 ? (h16)1.f : (h16)0.f;
  KLOAD(t0) VLOAD(t0) KWRITE(0) VWRITE(0)
  __syncthreads();
#pragma unroll 1
  for (int t = t0; t < t1; ++t) {
    const int st = (t - t0) & 1;
    const bool more = t + 1 < t1;
    if (more) { KLOAD(t + 1) VLOAD(t + 1) }
    const unsigned ka = (unsigned)(size_t)(Ks + st * 4608 + r * 72 + hh * 8);
    const unsigned va = (unsigned)(size_t)(Vs + st * 9216 + r * 72 + hh * 8);
    h8 a0, a1, a2, a3, b0, b1, b2, b3, g0, g1, g2, g3, g4, g5, g6, g7;
    lds_rd<0>(a0, ka); lds_rd<32>(a1, ka); lds_rd<64>(a2, ka); lds_rd<96>(a3, ka);
    lds_rd<4608 + 0>(b0, ka); lds_rd<4608 + 32>(b1, ka); lds_rd<4608 + 64>(b2, ka); lds_rd<4608 + 96>(b3, ka);
    lds_rd<0>(g0, va); lds_rd<32>(g1, va); lds_rd<4608>(g2, va); lds_rd<4608 + 32>(g3, va);
    lds_rd<9216>(g4, va); lds_rd<9216 + 32>(g5, va); lds_rd<13824>(g6, va); lds_rd<13824 + 32>(g7, va);
    f16v Sa = MFMA(kx, qx, zero16()), Sb = Sa;
    LGKM_WAIT4(12, a0, a1, a2, a3);
    Sa = MFMA(a0, qf[0], Sa); Sa = MFMA(a1, qf[1], Sa); Sa = MFMA(a2, qf[2], Sa); Sa = MFMA(a3, qf[3], Sa);
    LGKM_WAIT4(8, b0, b1, b2, b3);
    Sb = MFMA(b0, qf[0], Sb); Sb = MFMA(b1, qf[1], Sb); Sb = MFMA(b2, qf[2], Sb); Sb = MFMA(b3, qf[3], Sb);
    const float mprev = m;
    {
      h8 p0, p1;
      const float al = softmax_shifted(Sa, m, l, qx, t == t0, hh == 0, p0, p1);
      if (__any(al != 1.0f)) {
#pragma unroll
        for (int i = 0; i < 16; ++i) { O0[i] *= al; O1[i] *= al; O2[i] *= al; O3[i] *= al; }
      }
      LGKM_WAIT9(0, g0, g1, g2, g3, g4, g5, g6, g7, p0);
      O0 = MFMA(g0, p0, O0); O1 = MFMA(g2, p0, O1); O2 = MFMA(g4, p0, O2); O3 = MFMA(g6, p0, O3);
      O0 = MFMA(g1, p1, O0); O1 = MFMA(g3, p1, O1); O2 = MFMA(g5, p1, O2); O3 = MFMA(g7, p1, O3);
    }
    lds_rd<64>(g0, va); lds_rd<96>(g1, va); lds_rd<4608 + 64>(g2, va); lds_rd<4608 + 96>(g3, va);
    lds_rd<9216 + 64>(g4, va); lds_rd<9216 + 96>(g5, va); lds_rd<13824 + 64>(g6, va); lds_rd<13824 + 96>(g7, va);
    {
      h8 p0, p1;
      if (m != mprev) {
        const float d = m - mprev;
#pragma unroll
        for (int i = 0; i < 16; ++i) Sb[i] -= d;
      }
      const float al = softmax_shifted(Sb, m, l, qx, false, hh == 0, p0, p1);
      if (__any(al != 1.0f)) {
#pragma unroll
        for (int i = 0; i < 16; ++i) { O0[i] *= al; O1[i] *= al; O2[i] *= al; O3[i] *= al; }
      }
      LGKM_WAIT9(0, g0, g1, g2, g3, g4, g5, g6, g7, p0);
      O0 = MFMA(g0, p0, O0); O1 = MFMA(g2, p0, O1); O2 = MFMA(g4, p0, O2); O3 = MFMA(g6, p0, O3);
      O0 = MFMA(g1, p1, O0); O1 = MFMA(g3, p1, O1); O2 = MFMA(g5, p1, O2); O3 = MFMA(g7, p1, O3);
    }
    if (more) { KWRITE(st ^ 1) VWRITE(st ^ 1) }
    __syncthreads();
  }
#undef KLOAD
#undef KWRITE
#undef VLOAD
#undef VWRITE
  size_t Rm = R; asm volatile("" : "+v"(Rm));
  int hdm = hd; asm volatile("" : "+s"(hdm));
  const float il = 1.f / xhalf_sum(l);
  if (mp == 0) {
#pragma unroll
    for (int d = 0; d < 4; ++d)
#pragma unroll
      for (int g = 0; g < 4; ++g) {
        const int dv = d * 32 + 8 * g + 4 * hh;
        h4 ov;
#pragma unroll
        for (int e = 0; e < 4; ++e) {
          const float o = d == 0 ? O0[4 * g + e] : d == 1 ? O1[4 * g + e] : d == 2 ? O2[4 * g + e] : O3[4 * g + e];
          ov[e] = (h16)(o * il);
        }
        *(h4*)(AM + Rm * 512 + hdm * 128 + dv) = ov;
      }
  } else {
    const float f = lam * il;
    float ss = 0.f;
#pragma unroll
    for (int d = 0; d < 4; ++d)
#pragma unroll
      for (int g = 0; g < 4; ++g) {
        const int dv = d * 32 + 8 * g + 4 * hh;
        const h4 a1 = *(const h4*)(AM + Rm * 512 + hdm * 128 + dv);
#pragma unroll
        for (int e = 0; e < 4; ++e) {
          const float oo = d == 0 ? O0[4 * g + e] : d == 1 ? O1[4 * g + e] : d == 2 ? O2[4 * g + e] : O3[4 * g + e];
          const float o = (float)a1[e] - f * oo;
          if (d == 0) O0[4 * g + e] = o; else if (d == 1) O1[4 * g + e] = o; else if (d == 2) O2[4 * g + e] = o; else O3[4 * g + e] = o;
          ss += o * o;
        }
      }
    ss += __shfl_xor(ss, 32);
    const float rs = rsqrtf(ss * (1.f / 128.f) + 1e-6f) * (1.f - lam_init);
    const float* sg = p.da_subln_g + (layer >> 1) * 128;
    if (!dry) {
#pragma unroll
      for (int d = 0; d < 4; ++d)
#pragma unroll
        for (int g = 0; g < 4; ++g) {
          const int dv = d * 32 + 8 * g + 4 * hh;
          h16* yp = GY + Rm * 1024 + hdm * 128 + dv;
          h4 gv = *(const h4*)yp, ov;
#pragma unroll
          for (int e = 0; e < 4; ++e) {
            const float o = d == 0 ? O0[4 * g + e] : d == 1 ? O1[4 * g + e] : d == 2 ? O2[4 * g + e] : O3[4 * g + e];
            ov[e] = (h16)(o * rs * sg[dv + e] * (float)gv[e]);
          }
          *(h4*)yp = ov;
        }
    }
  }
  }
}

DI void da_item(const Params& p, int layer, int b, int hd, int qj0, int t0, int t1, float lam, float lam_init, char* smem, int dry) {
  da_map<0>(p, layer, b, hd, qj0, t0, t1, lam, lam_init, smem, dry);
  da_map<1>(p, layer, b, hd, qj0, t0, t1, lam, lam_init, smem, dry);
}

DI void mla_item(const Params& p, int b, int hd, int qj0, int t0, int t1, char* smem, int dry) {
  char* ws = p.ws; asm volatile("" : "+s"(ws));
  const h16* QM = (const h16*)(ws + OFF_QM);
  const h16* KN = (const h16*)(ws + OFF_KN);
  const h16* KR = (const h16*)(ws + OFF_KR);
  const h16* VMT = (const h16*)(ws + OFF_VMT);
  h16* GY = (h16*)(ws + OFF_GY);
  int tid = threadIdx.x; asm volatile("" : "+v"(tid));
  const int lane = tid & 63, w = tid >> 6, r = lane & 31, hh = lane >> 5;
  const size_t R = (size_t)b * TB + qj0 + w * 64 + r;
  h16* Ks = (h16*)smem;
  h16* Vs = (h16*)(smem + 2 * 13312);
  h8 qa[6], qb[6];
#pragma unroll
  for (int kk = 0; kk < 6; ++kk) {
    qa[kk] = *(const h8*)(QM + R * 768 + hd * 96 + kk * 16 + hh * 8);
    qb[kk] = *(const h8*)(QM + (R + 32) * 768 + hd * 96 + kk * 16 + hh * 8);
  }
  const float sc = 0.10206207261596575f * LOG2E;
  const h16* kng = KN + ((size_t)b * TB + (tid >> 3)) * 512 + hd * 64 + (tid & 7) * 8;
  const int knd = (tid >> 3) * 104 + (tid & 7) * 8;
  const h16* krg = KR + ((size_t)b * TB + (tid >> 2)) * 32 + (tid & 3) * 8;
  const int krd = (tid >> 2) * 104 + 64 + (tid & 3) * 8;
  const h16* vg = VMT + ((size_t)b * 512 + hd * 64 + (tid >> 3)) * TB + (tid & 7) * 8;
  const int vd = (tid >> 3) * 72 + (tid & 7) * 8;
  uint4 k0, k1, k2, v0, v1;
#define MLOAD(T) { const h16* s_ = kng + (size_t)(T) * 32768; k0 = *(const uint4*)s_; k1 = *(const uint4*)(s_ + 16384); k2 = *(const uint4*)(krg + (size_t)(T) * 2048); \
                   const h16* u_ = vg + (T) * 64; v0 = *(const uint4*)u_; v1 = *(const uint4*)(u_ + (size_t)32 * TB); }
#define MWRITE(ST) { h16* d_ = Ks + (ST) * 6656; *(uint4*)(d_ + knd) = k0; *(uint4*)(d_ + knd + 32 * 104) = k1; *(uint4*)(d_ + krd) = k2; \
                     h16* e_ = Vs + (ST) * 4608 + vd; *(uint4*)e_ = v0; *(uint4*)(e_ + 32 * 72) = v1; }
  f16v Oa0 = zero16(), Oa1 = zero16(), Ob0 = zero16(), Ob1 = zero16();
  float ma = 0.f, la = 0.f, mb = 0.f, lb = 0.f;
  h8 kx, qxa, qxb;
#pragma unroll
  for (int j = 0; j < 8; ++j) { kx[j] = (h16)0.f; qxa[j] = (h16)0.f; qxb[j] = (h16)0.f; }
  kx[0] = hh == 0 ? (h16)1.f : (h16)0.f;
  MLOAD(t0) MWRITE(0)
  __syncthreads();
#pragma unroll 1
  for (int t = t0; t < t1; ++t) {
    const int st = (t - t0) & 1;
    const bool more = t + 1 < t1;
    const unsigned ka = (unsigned)(size_t)(Ks + st * 6656 + r * 104 + hh * 8);
    const unsigned va = (unsigned)(size_t)(Vs + st * 4608 + r * 72 + hh * 8);
#pragma unroll 2
    for (int sub = 0; sub < 2; ++sub) {
      if (sub == 1 && more) MLOAD(t + 1)
      const unsigned kas = ka + sub * 6656, vas = va + sub * 64;
      h8 f0, f1, f2, f3, f4, f5, g0, g1, g2, g3;
      lds_rd<0>(f0, kas); lds_rd<32>(f1, kas); lds_rd<64>(f2, kas); lds_rd<96>(f3, kas); lds_rd<128>(f4, kas); lds_rd<160>(f5, kas);
      f16v Sa = MFMA(kx, qxa, zero16()), Sb = MFMA(kx, qxb, zero16());
      LGKM_WAIT6(0, f0, f1, f2, f3, f4, f5);
      Sa = MFMA(f0, qa[0], Sa); Sb = MFMA(f0, qb[0], Sb);
      Sa = MFMA(f1, qa[1], Sa); Sb = MFMA(f1, qb[1], Sb);
      Sa = MFMA(f2, qa[2], Sa); Sb = MFMA(f2, qb[2], Sb);
      Sa = MFMA(f3, qa[3], Sa); Sb = MFMA(f3, qb[3], Sb);
      Sa = MFMA(f4, qa[4], Sa); Sb = MFMA(f4, qb[4], Sb);
      Sa = MFMA(f5, qa[5], Sa); Sb = MFMA(f5, qb[5], Sb);
      lds_rd<0>(g0, vas); lds_rd<32>(g1, vas); lds_rd<4608>(g2, vas); lds_rd<4608 + 32>(g3, vas);
      h8 pa0, pa1, pb0, pb1;
      const bool first = (t == t0) && (sub == 0);
      const float ala = softmax_shifted(Sa, ma, la, qxa, first, hh == 0, pa0, pa1);
      if (__any(ala != 1.0f)) {
#pragma unroll
        for (int i = 0; i < 16; ++i) { Oa0[i] *= ala; Oa1[i] *= ala; }
      }
      const float alb = softmax_shifted(Sb, mb, lb, qxb, first, hh == 0, pb0, pb1);
      if (__any(alb != 1.0f)) {
#pragma unroll
        for (int i = 0; i < 16; ++i) { Ob0[i] *= alb; Ob1[i] *= alb; }
      }
      LGKM_WAIT6(0, g0, g1, g2, g3, pa0, pb0);
      Oa0 = MFMA(g0, pa0, Oa0); Ob0 = MFMA(g0, pb0, Ob0);
      Oa1 = MFMA(g2, pa0, Oa1); Ob1 = MFMA(g2, pb0, Ob1);
      Oa0 = MFMA(g1, pa1, Oa0); Ob0 = MFMA(g1, pb1, Ob0);
      Oa1 = MFMA(g3, pa1, Oa1); Ob1 = MFMA(g3, pb1, Ob1);
    }
    if (more) MWRITE(st ^ 1)
    __syncthreads();
  }
#undef MLOAD
#undef MWRITE
  const float ia = 1.f / xhalf_sum(la), ib = 1.f / xhalf_sum(lb);
  if (!dry) {
#pragma unroll
    for (int d = 0; d < 2; ++d)
#pragma unroll
      for (int g = 0; g < 4; ++g) {
        const int dv = d * 32 + 8 * g + 4 * hh;
        {
          h16* yp = GY + R * 1024 + 512 + hd * 64 + dv;
          h4 gv = *(const h4*)yp, ov;
#pragma unroll
          for (int e = 0; e < 4; ++e) ov[e] = (h16)((d ? Oa1[4 * g + e] : Oa0[4 * g + e]) * ia * (float)gv[e]);
          *(h4*)yp = ov;
        }
        {
          h16* yp = GY + (R + 32) * 1024 + 512 + hd * 64 + dv;
          h4 gv = *(const h4*)yp, ov;
#pragma unroll
          for (int e = 0; e < 4; ++e) ov[e] = (h16)((d ? Ob1[4 * g + e] : Ob0[4 * g + e]) * ib * (float)gv[e]);
          *(h4*)yp = ov;
        }
      }
  }
}

DI void na_wave(const Params& p, int layer, int b, int gr, int hp, char* smem, int dry) {
  char* ws = p.ws; asm volatile("" : "+s"(ws));
  const h16* NAQ = (const h16*)(ws + OFF_NAQ);
  const h16* NAK = (const h16*)(ws + OFF_NAK);
  const h16* NAVT = (const h16*)(ws + OFF_NAVT);
  h16* GY = (h16*)(ws + OFF_GY);
  int tid_ = threadIdx.x; asm volatile("" : "+v"(tid_));
  const int lane = tid_ & 63, w = tid_ >> 6, r = lane & 31, hh = lane >> 5;
  const int hd = hp * 2 + (w >> 1), half = w & 1;
  float* tbl = (float*)smem;
  __syncthreads();
  for (int i = tid_; i < 2 * 465; i += 256) {
    const int hs = i >= 465, j = i - hs * 465;
    tbl[hs * 480 + j] = p.na_rpb[((size_t)(layer >> 1) * 8 + hp * 2 + hs) * 465 + j];
  }
  __syncthreads();
  const float* rpb = tbl + (w >> 1) * 480;
  const int c = half * 32 + r;
  const int cs = min(max(c - 8, 0), 48);
  const int rs = min(max(gr - 4, 0), 120);
  const size_t R = (size_t)b * TB + gr * 64 + c;
  h8 qf[4];
#pragma unroll
  for (int kk = 0; kk < 4; ++kk) qf[kk] = *(const h8*)(NAQ + R * 512 + hd * 64 + kk * 16 + hh * 8);
  f16v O0 = zero16(), O1 = zero16();
  float m = -1e30f, l = 0.f;
  const float sc = 0.125f * LOG2E;
  const h16* kbase = NAK + ((size_t)b * TB + r) * 512 + hd * 64 + hh * 8;
  const h16* vbase = NAVT + ((size_t)b * 512 + hd * 64 + r) * TB + 8 * hh;
  auto tile_j0 = [&](int t) { return t < 16 ? (rs + (t >> 1)) * 64 + (t & 1) * 32 : SEQ + (t - 16) * 32; };
  struct Fr { h8 k0, k1, k2, k3, v00, v01, v10, v11; };
  auto load = [&](int t) {
    const int j0 = tile_j0(t);
    const h16* kp = kbase + (size_t)j0 * 512;
    const h16* vb = vbase + j0;
    Fr f;
    f.k0 = *(const h8*)(kp); f.k1 = *(const h8*)(kp + 16); f.k2 = *(const h8*)(kp + 32); f.k3 = *(const h8*)(kp + 48);
    f.v00 = *(const h8*)(vb); f.v01 = *(const h8*)(vb + 16);
    f.v10 = *(const h8*)(vb + (size_t)32 * TB); f.v11 = *(const h8*)(vb + (size_t)32 * TB + 16);
    return f;
  };
  auto compute = [&](const Fr& f, int t) {
    f16v S = zero16();
    S = MFMA(f.k0, qf[0], S); S = MFMA(f.k1, qf[1], S); S = MFMA(f.k2, qf[2], S); S = MFMA(f.k3, qf[3], S);
    float mx = -1e30f;
    if (t < 16) {
      const int krow_g = rs + (t >> 1), kc0 = (t & 1) * 32;
      const float* bp = rpb + (krow_g - gr + 7) * 31 + (15 - c);
#pragma unroll
      for (int i = 0; i < 16; ++i) {
        const int kj = kc0 + crow(i, hh);
        const bool valid = (kj >= cs) && (kj < cs + 16);
        float v = -1e30f;
        if (valid) v = (S[i] * 0.125f + bp[kj]) * LOG2E;
        S[i] = v;
        mx = fmaxf(mx, v);
      }
    } else {
#pragma unroll
      for (int i = 0; i < 16; ++i) { S[i] *= sc; mx = fmaxf(mx, S[i]); }
    }
    mx = xhalf_max(mx);
    const float mn = fmaxf(m, mx);
    const float alpha = __builtin_amdgcn_exp2f(m - mn);
    float sum = 0.f;
#pragma unroll
    for (int i = 0; i < 16; ++i) {
      float pv = (S[i] > -1e29f) ? __builtin_amdgcn_exp2f(S[i] - mn) : 0.f;
      sum += pv;
      S[i] = pv;
    }
    l = l * alpha + sum;
    m = mn;
    h8 p0, p1;
#pragma unroll
    for (int j = 0; j < 8; ++j) { p0[j] = (h16)S[j]; p1[j] = (h16)S[8 + j]; }
    if (__any(alpha != 1.0f)) {
#pragma unroll
      for (int i = 0; i < 16; ++i) { O0[i] *= alpha; O1[i] *= alpha; }
    }
    O0 = MFMA(f.v00, p0, O0); O0 = MFMA(f.v01, p1, O0);
    O1 = MFMA(f.v10, p0, O1); O1 = MFMA(f.v11, p1, O1);
  };
  Fr fa = load(0);
#pragma unroll 1
  for (int t = 0; t < 24; t += 2) {
    Fr fb = load(t + 1);
    __builtin_amdgcn_sched_barrier(0);
    compute(fa, t);
    __builtin_amdgcn_sched_barrier(0);
    if (t + 2 < 24) fa = load(t + 2);
    __builtin_amdgcn_sched_barrier(0);
    compute(fb, t + 1);
    __builtin_amdgcn_sched_barrier(0);
  }
  l += __shfl_xor(l, 32);
  const float il = 1.f / l;
  if (!dry)
#pragma unroll
  for (int d = 0; d < 2; ++d)
#pragma unroll
    for (int g = 0; g < 4; ++g) {
      const int dv = d * 32 + 8 * g + 4 * hh;
      h16* yp = GY + R * 1024 + 512 + hd * 64 + dv;
      h4 gv = *(const h4*)yp, ov;
#pragma unroll
      for (int e = 0; e < 4; ++e) ov[e] = (h16)((d ? O1[4 * g + e] : O0[4 * g + e]) * il * (float)gv[e]);
      *(h4*)yp = ov;
    }
}

DI void nactx_item(const Params& p, int b, int hd, int qt, int dry) {
  char* ws = p.ws; asm volatile("" : "+s"(ws));
  const h16* NAQ = (const h16*)(ws + OFF_NAQ);
  const h16* NAK = (const h16*)(ws + OFF_NAK);
  const h16* NAVT = (const h16*)(ws + OFF_NAVT);
  h16* GY = (h16*)(ws + OFF_GY);
  int tid_ = threadIdx.x; asm volatile("" : "+v"(tid_));
  const int lane = tid_ & 63, w = tid_ >> 6, r = lane & 31, hh = lane >> 5;
  const size_t R = (size_t)b * TB + SEQ + qt * 128 + w * 32 + r;
  h8 qf[1][4];
#pragma unroll
  for (int kk = 0; kk < 4; ++kk) qf[0][kk] = *(const h8*)(NAQ + R * 512 + hd * 64 + kk * 16 + hh * 8);
  f16v O[1][2];
  O[0][0] = zero16(); O[0][1] = zero16();
  float mm[1] = {-1e30f}, ll[1] = {0.f};
  const h16* kb = NAK + ((size_t)b * TB + r) * 512 + hd * 64 + hh * 8;
  const h16* vbase = NAVT + ((size_t)b * 512 + hd * 64 + r) * TB + 8 * hh;
  flash_wave<1, 4, 2>(qf, O, mm, ll, 256, 264, 0.125f * LOG2E,
      [&](int m, int kk, int t) { return *(const h8*)(kb + (size_t)t * 32 * 512 + kk * 16); },
      [&](int d, int t, int s) { return *(const h8*)(vbase + (size_t)d * 32 * TB + t * 32 + 16 * s); });
  const float l1 = ll[0] + __shfl_xor(ll[0], 32);
  const float i1 = 1.f / l1;
  if (!dry)
#pragma unroll
  for (int d = 0; d < 2; ++d)
#pragma unroll
    for (int g = 0; g < 4; ++g) {
      const int dv = d * 32 + 8 * g + 4 * hh;
      h16* yp = GY + R * 1024 + 512 + hd * 64 + dv;
      h4 gv = *(const h4*)yp, ov;
#pragma unroll
      for (int e = 0; e < 4; ++e) ov[e] = (h16)(O[0][d][4 * g + e] * i1 * (float)gv[e]);
      *(h4*)yp = ov;
    }
}

DI int chunk_j0(int dir, int k) {
  if (k < 2) return SEQ + (dir ? 1 - k : k) * 128;
  return (dir ? 63 - (k - 2) : (k - 2)) * 128;
}
DI int tokchunk_k(int dir, int kc) {
  if (kc >= 64) { int cc = kc - 64; return dir ? 1 - cc : cc; }
  return 2 + (dir ? 63 - kc : kc);
}

DI void scan_sum2(float v0, float v1, int lane, float& o0, float& o1) {
  float s = v0 + v1;
#pragma unroll
  for (int off = 1; off < 64; off <<= 1) { float t = __shfl_up(s, off); if (lane >= off) s += t; }
  o1 = s; o0 = s - v1;
}
DI void scan_max2(float v0, float v1, int lane, float& o0, float& o1) {
  float s = fmaxf(v0, v1);
#pragma unroll
  for (int off = 1; off < 64; off <<= 1) { float t = __shfl_up(s, off); if (lane >= off) s = fmaxf(s, t); }
  float ex = __shfl_up(s, 1);
  if (lane == 0) ex = -1e30f;
  o1 = s; o0 = fmaxf(ex, v0);
}

DI void conv8(const h16* __restrict__ QKP, size_t rowbase, int pidx, int col, bool has_prev, bool has_next,
              const float* __restrict__ cw, const float* __restrict__ cb, float (&y)[8]) {
  {
    const float4 b0 = *(const float4*)(cb + col), b1 = *(const float4*)(cb + col + 4);
    y[0] = b0.x; y[1] = b0.y; y[2] = b0.z; y[3] = b0.w; y[4] = b1.x; y[5] = b1.y; y[6] = b1.z; y[7] = b1.w;
  }
#pragma unroll
  for (int t = 0; t < 5; ++t) {
    const int pp = pidx + t - 2;
    const bool ok = (pp >= 0 || has_prev) && (pp < 128 || has_next);
    if (ok) {
      const h8 xv = *(const h8*)(QKP + (size_t)((long)rowbase + pp) * 1024 + col);
      const float4 w0 = *(const float4*)(cw + t * 1024 + col), w1 = *(const float4*)(cw + t * 1024 + col + 4);
      y[0] += (float)xv[0] * w0.x; y[1] += (float)xv[1] * w0.y; y[2] += (float)xv[2] * w0.z; y[3] += (float)xv[3] * w0.w;
      y[4] += (float)xv[4] * w1.x; y[5] += (float)xv[5] * w1.y; y[6] += (float)xv[6] * w1.z; y[7] += (float)xv[7] * w1.w;
    }
  }
#pragma unroll
  for (int e = 0; e < 8; ++e) y[e] = silu_f(y[e]);
}

struct ConvW { float4 w[5][2]; float4 b[2]; };
DI ConvW load_convw(const float* __restrict__ cw, const float* __restrict__ cb, int col) {
  ConvW c;
#pragma unroll
  for (int t = 0; t < 5; ++t) { c.w[t][0] = *(const float4*)(cw + t * 1024 + col); c.w[t][1] = *(const float4*)(cw + t * 1024 + col + 4); }
  c.b[0] = *(const float4*)(cb + col); c.b[1] = *(const float4*)(cb + col + 4);
  return c;
}
DI void conv8w(const h16* __restrict__ QKP, size_t rowbase, int pidx, int col, bool has_prev, bool has_next, const ConvW& c, float (&y)[8]) {
  y[0] = c.b[0].x; y[1] = c.b[0].y; y[2] = c.b[0].z; y[3] = c.b[0].w; y[4] = c.b[1].x; y[5] = c.b[1].y; y[6] = c.b[1].z; y[7] = c.b[1].w;
#pragma unroll
  for (int t = 0; t < 5; ++t) {
    const int pp = pidx + t - 2;
    const bool ok = (pp >= 0 || has_prev) && (pp < 128 || has_next);
    if (ok) {
      const h8 xv = *(const h8*)(QKP + (size_t)((long)rowbase + pp) * 1024 + col);
      y[0] += (float)xv[0] * c.w[t][0].x; y[1] += (float)xv[1] * c.w[t][0].y; y[2] += (float)xv[2] * c.w[t][0].z; y[3] += (float)xv[3] * c.w[t][0].w;
      y[4] += (float)xv[4] * c.w[t][1].x; y[5] += (float)xv[5] * c.w[t][1].y; y[6] += (float)xv[6] * c.w[t][1].z; y[7] += (float)xv[7] * c.w[t][1].w;
    }
  }
#pragma unroll
  for (int e = 0; e < 8; ++e) y[e] = silu_f(y[e]);
}

constexpr float K_SCALE = 0.08838834764831845f;

DI void m1_item(const Params& p, int layer, int c, int k, char* smem) {
  char* ws = p.ws; asm volatile("" : "+s"(ws));
  const h16* QKP = (const h16*)(ws + OFF_QKP);
  const h16* MVT = (const h16*)(ws + OFF_MVT);
  const float* GT = (const float*)(ws + OFF_GT);
  h16* UT = (h16*)(ws + OFF_H);
  float* BT = (float*)(ws + OFF_BT);
  float* GM = (float*)(ws + OFF_GM);
  float* NL = (float*)(ws + OFF_NL);
  const int li_ = layer >> 1;
  const int dir = c & 1, hd = (c >> 1) & 3, b = c >> 3;
  const int j0 = chunk_j0(dir, k);
  const size_t R0 = (size_t)b * TB + j0;
  h16* KT = (h16*)smem;
  float* WL = (float*)(smem + 128 * 136 * 2);
  int tid = threadIdx.x; asm volatile("" : "+v"(tid));
  const int lane = tid & 63, w = tid >> 6, r = lane & 31, hh = lane >> 5;
  if (w == 0) {
    const int r0 = 2 * lane, r1 = r0 + 1;
    const int p0 = dir ? 127 - r0 : r0, p1 = dir ? 127 - r1 : r1;
    const float fb = p.ml_f_bias[(li_ * 2 + dir) * 4 + hd];
    const float li0 = GT[(R0 + p0) * 16 + (2 * dir) * 4 + hd], li1 = GT[(R0 + p1) * 16 + (2 * dir) * 4 + hd];
    const float lf0 = logsig_f(GT[(R0 + p0) * 16 + (2 * dir + 1) * 4 + hd] + fb);
    const float lf1 = logsig_f(GT[(R0 + p1) * 16 + (2 * dir + 1) * 4 + hd] + fb);
    float bc0, bc1;
    scan_sum2(lf0, lf1, lane, bc0, bc1);
    const float btot = __shfl(bc1, 63);
    const float g0 = btot - bc0 + li0, g1 = btot - bc1 + li1;
    float gm = fmaxf(g0, g1);
#pragma unroll
    for (int off = 32; off > 0; off >>= 1) gm = fmaxf(gm, __shfl_xor(gm, off));
    WL[p0] = __expf(g0 - gm);
    WL[p1] = __expf(g1 - gm);
    if (lane == 0) { BT[c * NCHUNK + k] = btot; GM[c * NCHUNK + k] = gm; }
  }
  __syncthreads();
  const bool has_prev = (j0 != 0) && (j0 != SEQ);
  const bool has_next = (j0 + 128 != SEQ) && (j0 + 128 != TB);
  const float* cw = p.ml_conv_w + (size_t)li_ * 5 * 1024;
  const float* cb = p.ml_conv_b + (size_t)li_ * 1024;
  const ConvW cvw = load_convw(cw, cb, 512 + hd * 128 + (tid & 15) * 8);
#pragma unroll 4
  for (int it = tid; it < 128 * 16; it += 256) {
    const int pp = it >> 4, ch0 = (it & 15) * 8;
    float y[8];
    conv8w(QKP, R0, pp, 512 + hd * 128 + ch0, has_prev, has_next, cvw, y);
    const float wv = WL[pp] * K_SCALE;
    const int o16 = pp & 15;
    const int ppos = (pp & ~15) | ((o16 & 3) | ((o16 & 4) << 1) | ((o16 & 8) >> 1));
#pragma unroll
    for (int e = 0; e < 8; ++e) KT[(ch0 + e) * 136 + ppos] = (h16)(y[e] * wv);
  }
  __syncthreads();
  if (tid < 128) {
    float s = 0.f;
#pragma unroll 8
    for (int q = 0; q < 128; ++q) s += (float)KT[tid * 136 + q];
    NL[((size_t)c * NCHUNK + k) * 128 + tid] = s;
  }
  f16v acc[4];
#pragma unroll
  for (int d = 0; d < 4; ++d) acc[d] = zero16();
  const h16* vp = MVT + ((size_t)b * 512 + hd * 128 + w * 32 + r) * TB + j0 + hh * 8;
  h8 af[8];
#pragma unroll
  for (int ks = 0; ks < 8; ++ks) af[ks] = *(const h8*)(vp + ks * 16);
  __builtin_amdgcn_sched_barrier(0);
#pragma unroll
  for (int ks = 0; ks < 8; ++ks) {
#pragma unroll
    for (int d = 0; d < 4; ++d) {
      const h8 bb = *(const h8*)(KT + (d * 32 + r) * 136 + ks * 16 + hh * 8);
      acc[d] = MFMA(af[ks], bb, acc[d]);
    }
  }
  h16* up = UT + ((size_t)c * NCHUNK + k) * 16384;
#pragma unroll
  for (int d = 0; d < 4; ++d)
#pragma unroll
    for (int i = 0; i < 16; ++i) up[(w * 32 + crow(i, hh)) * 128 + d * 32 + r] = (h16)acc[d][i];
  __syncthreads();
}

DI void m3_item(const Params& p, int layer, int b, int hd, int kc, char* smem, int dry) {
  char* ws = p.ws; asm volatile("" : "+s"(ws));
  const h16* QKP = (const h16*)(ws + OFF_QKP);
  const h16* MVT = (const h16*)(ws + OFF_MVT);
  const h16* OG = (const h16*)(ws + OFF_OG);
  const float* GT = (const float*)(ws + OFF_GT);
  const h16* UT = (const h16*)(ws + OFF_H);
  const float* MP = (const float*)(ws + OFF_MP);
  const float* NL = (const float*)(ws + OFF_NL);
  h16* GY = (h16*)(ws + OFF_GY);
  const int li_ = layer >> 1;
  const int j0 = kc < 64 ? kc * 128 : SEQ + (kc - 64) * 128;
  const size_t R0 = (size_t)b * TB + j0;
  h16* Qs = (h16*)smem;
  h16* Ks = Qs + 128 * 136;
  float* BC = (float*)(smem + 2 * 128 * 136 * 2);
  float* AA = BC + 128;
  float* MT = AA + 128;
  float* NP = MT + 128;
  int tid = threadIdx.x; asm volatile("" : "+v"(tid));
  const int lane = tid & 63, w = tid >> 6, r = lane & 31, hh = lane >> 5;
  const bool has_prev = (j0 != 0) && (j0 != SEQ);
  const bool has_next = (j0 + 128 != SEQ) && (j0 + 128 != TB);
  const float* cw = p.ml_conv_w + (size_t)li_ * 5 * 1024;
  const float* cb = p.ml_conv_b + (size_t)li_ * 1024;
  const ConvW cvw = load_convw(cw, cb, ((tid & 31) >> 4) * 512 + hd * 128 + (tid & 15) * 8);
#pragma unroll 4
  for (int it = tid; it < 128 * 32; it += 256) {
    const int pp = it >> 5, cg = it & 31, which = cg >> 4, ch0 = (cg & 15) * 8;
    float y[8];
    conv8w(QKP, R0, pp, which * 512 + hd * 128 + ch0, has_prev, has_next, cvw, y);
    h8 o;
    const float sc = which ? K_SCALE : 1.f;
#pragma unroll
    for (int e = 0; e < 8; ++e) o[e] = (h16)(y[e] * sc);
    *(h8*)((which ? Ks : Qs) + pp * 136 + ch0) = o;
  }
  __syncthreads();
  const int tq = w * 32 + r;
  const unsigned qad = (unsigned)(size_t)(Qs + tq * 136 + hh * 8);
#define LOADQ(q) { lds_rd<0>(q[0], qad); lds_rd<32>(q[1], qad); lds_rd<64>(q[2], qad); lds_rd<96>(q[3], qad); \
                   lds_rd<128>(q[4], qad); lds_rd<160>(q[5], qad); lds_rd<192>(q[6], qad); lds_rd<224>(q[7], qad); \
                   LGKM_WAIT8(0, q[0], q[1], q[2], q[3], q[4], q[5], q[6], q[7]); }
  f16v hs[4];
#pragma unroll
  for (int d = 0; d < 4; ++d) hs[d] = zero16();
#pragma unroll 1
  for (int dir = 0; dir < 2; ++dir) {
    const int c = (b * 4 + hd) * 2 + dir;
    const int k = tokchunk_k(dir, kc);
    const float mprev = MP[c * NCHUNK + k];
    if (w == 0) {
      const int r0 = 2 * lane, r1 = r0 + 1;
      const int p0 = dir ? 127 - r0 : r0, p1 = dir ? 127 - r1 : r1;
      const float fb = p.ml_f_bias[(li_ * 2 + dir) * 4 + hd];
      const float li0 = GT[(R0 + p0) * 16 + (2 * dir) * 4 + hd], li1 = GT[(R0 + p1) * 16 + (2 * dir) * 4 + hd];
      const float lf0 = logsig_f(GT[(R0 + p0) * 16 + (2 * dir + 1) * 4 + hd] + fb);
      const float lf1 = logsig_f(GT[(R0 + p1) * 16 + (2 * dir + 1) * 4 + hd] + fb);
      float bc0, bc1, pm0, pm1;
      scan_sum2(lf0, lf1, lane, bc0, bc1);
      const float a0 = li0 - bc0, a1 = li1 - bc1;
      scan_max2(a0, a1, lane, pm0, pm1);
      BC[p0] = bc0; BC[p1] = bc1; AA[p0] = a0; AA[p1] = a1;
      MT[p0] = fmaxf(mprev, pm0); MT[p1] = fmaxf(mprev, pm1);
    } else if (w == 1) {
      NP[lane] = NL[((size_t)c * NCHUNK + k) * 128 + lane];
      NP[lane + 64] = NL[((size_t)c * NCHUNK + k) * 128 + lane + 64];
    }
    __syncthreads();
    const float mt = MT[tq];
    const float wc = __expf(mprev - mt);
    f16v acc[4];
    float qn = 0.f;
    {
    h8 qf[8];
    LOADQ(qf)
    const h16* cp = UT + ((size_t)c * NCHUNK + k) * 16384 + (size_t)r * 128 + hh * 8;
#pragma unroll
    for (int d = 0; d < 4; ++d) {
      acc[d] = zero16();
      h8 cf[8];
#pragma unroll
      for (int kk = 0; kk < 8; ++kk) cf[kk] = *(const h8*)(cp + d * 32 * 128 + kk * 16);
      __builtin_amdgcn_sched_barrier(0);
#pragma unroll
      for (int kk = 0; kk < 8; ++kk) acc[d] = MFMA(cf[kk], qf[kk], acc[d]);
#pragma unroll
      for (int i = 0; i < 16; ++i) acc[d][i] *= wc;
      __builtin_amdgcn_sched_barrier(0);
    }
#pragma unroll
    for (int kk = 0; kk < 8; ++kk)
#pragma unroll
      for (int e = 0; e < 8; ++e) qn += (float)qf[kk][e] * NP[kk * 16 + hh * 8 + e];
    }
    qn += __shfl_xor(qn, 32);
    float den = 0.f;
    const int st0 = dir ? w : 0, st1 = dir ? 4 : w + 1;
#pragma unroll 1
    for (int st = st0; st < st1; ++st) {
      f16v S = zero16();
      {
        h8 qf[8];
        LOADQ(qf)
        h8 kf[8];
#pragma unroll
        for (int kk = 0; kk < 8; ++kk) kf[kk] = *(const h8*)(Ks + (st * 32 + r) * 136 + kk * 16 + hh * 8);
        __builtin_amdgcn_sched_barrier(0);
#pragma unroll
        for (int kk = 0; kk < 8; ++kk) S = MFMA(kf[kk], qf[kk], S);
        __builtin_amdgcn_sched_barrier(0);
      }
      const h16* vb = MVT + ((size_t)b * 512 + hd * 128 + r) * TB + j0 + st * 32 + 8 * hh;
      h8 vf[8];
#pragma unroll
      for (int d = 0; d < 4; ++d) { vf[2 * d] = *(const h8*)(vb + (size_t)d * 32 * TB); vf[2 * d + 1] = *(const h8*)(vb + (size_t)d * 32 * TB + 16); }
      __builtin_amdgcn_sched_barrier(0);
#pragma unroll
      for (int i = 0; i < 16; ++i) {
        const int s = st * 32 + crow(i, hh);
        const bool valid = dir ? (s >= tq) : (s <= tq);
        float wgt = valid ? __expf(AA[s] - mt) * S[i] : 0.f;
        den += wgt;
        S[i] = wgt;
      }
      h8 p0, p1;
#pragma unroll
      for (int j = 0; j < 8; ++j) { p0[j] = (h16)S[j]; p1[j] = (h16)S[8 + j]; }
#pragma unroll
      for (int d = 0; d < 4; ++d) {
        acc[d] = MFMA(vf[2 * d], p0, acc[d]);
        acc[d] = MFMA(vf[2 * d + 1], p1, acc[d]);
      }
    }
    den += __shfl_xor(den, 32);
    den += wc * qn;
    const float dn = fmaxf(fabsf(den), __expf(-(BC[tq] + mt)));
    const float idn = 1.f / dn;
#pragma unroll
    for (int d = 0; d < 4; ++d)
#pragma unroll
      for (int i = 0; i < 16; ++i) hs[d][i] += acc[d][i] * idn;
    __syncthreads();
  }
  float sm = 0.f;
#pragma unroll
  for (int d = 0; d < 4; ++d)
#pragma unroll
    for (int i = 0; i < 16; ++i) sm += hs[d][i];
  sm += __shfl_xor(sm, 32);
  const float mu = sm * (1.f / 128.f);
  float vs = 0.f;
#pragma unroll
  for (int d = 0; d < 4; ++d)
#pragma unroll
    for (int i = 0; i < 16; ++i) { float dlt = hs[d][i] - mu; vs += dlt * dlt; }
  vs += __shfl_xor(vs, 32);
  const float rstd = rsqrtf(vs * (1.f / 128.f) + 1e-5f);
  const float* ng = p.ml_norm_g + (size_t)li_ * 512 + hd * 128;
  const size_t R = R0 + tq;
  if (!dry)
#pragma unroll
  for (int d = 0; d < 4; ++d)
#pragma unroll
    for (int g = 0; g < 4; ++g) {
      const int dv = d * 32 + 8 * g + 4 * hh;
      h16* yp = GY + R * 1024 + hd * 128 + dv;
      const h4 gv = *(const h4*)yp;
      const h4 og = *(const h4*)(OG + R * 512 + hd * 128 + dv);
      h4 ov;
#pragma unroll
      for (int e = 0; e < 4; ++e)
        ov[e] = (h16)((hs[d][4 * g + e] - mu) * rstd * ng[dv + e] * (float)og[e] * (float)gv[e]);
      *(h4*)yp = ov;
    }
}


#undef LOADQ
#define XB_TMO      128
#define XB_XCNT(j)  (256  + 64 * (j))
#define XB_XSUB(j)  (1280 + 64 * (j))
#define XB_XGEN(j)  (2304 + 64 * (j))
#define XB_TOP      3328
#define XB_TOPGEN   3392
#define XCD_BAR_WORDS 3456
#define XB_SPIN_CAP (1u << 22)
#define LAS __attribute__((address_space(3)))
DI unsigned xb_ld(unsigned* p) { return __hip_atomic_load(p, __ATOMIC_RELAXED, __HIP_MEMORY_SCOPE_AGENT); }
DI unsigned xb_add(unsigned* p, unsigned v) { return __hip_atomic_fetch_add(p, v, __ATOMIC_RELAXED, __HIP_MEMORY_SCOPE_AGENT); }
DI unsigned xb_xcc_id() { return (unsigned)__builtin_amdgcn_s_getreg((3 << 11) | 20) & 0xFu; }
#define XB_SPIN(cond, bar) do { unsigned _sp = 0; while (cond) { __builtin_amdgcn_s_sleep(1); \
    if ((++_sp & 255u) == 0u) { if (xb_ld(&(bar)[XB_TMO])) break; if (_sp > XB_SPIN_CAP) { atomicAdd(&(bar)[XB_TMO], 1u); break; } } } } while (0)
struct XcdBarrier { unsigned* bar; unsigned x; volatile LAS unsigned* st; };
DI XcdBarrier xcd_barrier_post(unsigned* bar, volatile LAS unsigned* st) {
  XcdBarrier b; b.bar = bar; b.x = xb_xcc_id(); b.st = st;
  if (threadIdx.x == 0) (void)xb_add(&bar[XB_XCNT(b.x)], 1u);
  return b;
}
DI void xcd_barrier_complete(unsigned* bar, unsigned x, unsigned& nloc, unsigned& nx) {
  const unsigned G = gridDim.x * gridDim.y * gridDim.z;
  unsigned sum, cnt, mine, sp = 0u;
  for (;;) {
    sum = 0u; cnt = 0u; mine = 0u;
#pragma unroll
    for (unsigned j = 0; j < 16; ++j) { const unsigned c = xb_ld(&bar[XB_XCNT(j)]); sum += c; cnt += (c > 0u) ? 1u : 0u; mine = (j == x) ? c : mine; }
    if (sum == G) break;
    __builtin_amdgcn_s_sleep(1);
    if ((++sp & 255u) == 0u) { if (xb_ld(&bar[XB_TMO])) break; if (sp > XB_SPIN_CAP) { atomicAdd(&bar[XB_TMO], 1u); break; } }
  }
  nloc = mine > 0u ? mine : 1u; nx = cnt > 0u ? cnt : 1u;
}
DI void xcd_barrier(const XcdBarrier& b) {
  asm volatile("s_waitcnt vmcnt(0)" ::: "memory");
  __syncthreads();
  if (threadIdx.x == 0) {
    unsigned* bar = b.bar; asm volatile("" : "+s"(bar));
    unsigned bx = b.x; asm volatile("" : "+s"(bx));
    __builtin_amdgcn_s_waitcnt(0);
    unsigned nloc = b.st[0], nx = b.st[1];
    if (nloc == 0u) { xcd_barrier_complete(bar, bx, nloc, nx); b.st[0] = nloc; b.st[1] = nx; }
    const unsigned old = xb_add(&bar[XB_XSUB(bx)], 1u);
    const unsigned gen = old / nloc;
    if (old + 1u == (gen + 1u) * nloc) {
      __builtin_amdgcn_fence(__ATOMIC_RELEASE, "agent");
      asm volatile("s_waitcnt vmcnt(0)" ::: "memory");
      const unsigned og = xb_add(&bar[XB_TOP], 1u);
      const unsigned tg = og / nx;
      if (og + 1u == (tg + 1u) * nx) xb_add(&bar[XB_TOPGEN], 1u);
      else XB_SPIN(xb_ld(&bar[XB_TOPGEN]) == tg, bar);
      __builtin_amdgcn_fence(__ATOMIC_ACQUIRE, "agent");
      xb_add(&bar[XB_XGEN(bx)], 1u);
      asm volatile("s_waitcnt vmcnt(0)" ::: "memory");
    } else {
      XB_SPIN(xb_ld(&bar[XB_XGEN(bx)]) == gen, bar);
      __builtin_amdgcn_fence(__ATOMIC_ACQUIRE, "agent");
      asm volatile("s_waitcnt vmcnt(0)" ::: "memory");
    }
  }
  __syncthreads();
}

__global__ void __launch_bounds__(256, 2) fwd_megakernel(Params p) {
  cg::grid_group grid = cg::this_grid();
  __shared__ __attribute__((aligned(16))) char smem[74240];
  char* ws = p.ws;
  const int tid = threadIdx.x, lane = tid & 63, w = tid >> 6;
  const int nblk = gridDim.x, bid = blockIdx.x;

  h16* WEV = (h16*)(ws + OFF_WEV);
  h16* WOD = (h16*)(ws + OFF_WOD);
  h16* WOUT = (h16*)(ws + OFF_WOUT);
  h16* WUQ = (h16*)(ws + OFF_WUQ);
  h16* WUKV = (h16*)(ws + OFF_WUKV);
  float* MOD = (float*)(ws + OFF_MOD);
  float* RDA = (float*)(ws + OFF_RDA);
  float* RML = (float*)(ws + OFF_RML);
  h16* X16 = (h16*)(ws + OFF_X16);
  h16* GY = (h16*)(ws + OFF_GY);
  h16* H = (h16*)(ws + OFF_H);
  h16* T = (h16*)(ws + OFF_T);

  __shared__ uint4 xb_words;
  unsigned* xbar = (unsigned*)(ws + OFF_BAR);
  if (tid == 0) xb_words = make_uint4(0u, 0u, 0u, 0u);
  if (bid == 0) for (int i = tid; i < XCD_BAR_WORDS; i += 256) xbar[i] = 0u;
  __syncthreads();
  {
    constexpr int N_ADA = 192;
    constexpr int T_EV = 16 * 48, T_OD = 16 * 76, T_OUT = 256, T_UQ = 4 * 12, T_UKV = 2 * 16;
    constexpr int N_TR = 2 * T_EV + 2 * T_OD + 4 * T_OUT + 2 * T_UQ + 2 * T_UKV;
    float* lds = (float*)smem;
    for (int it = bid; it < N_ADA + N_TR; it += nblk) {
      if (it < N_ADA) {
        float* scond = lds;
        float* red = lds + 5120;
        for (int idx = tid; idx < 5120; idx += 256) {
          const int rr = idx >> 10, d = idx & 1023;
          const float v = rr < 4 ? p.c[rr * 1024 + d] : p.c_ctx[d];
          scond[idx] = silu_f(v);
        }
        __syncthreads();
        const int col = it * 64 + (tid & 63), q = tid >> 6;
        const int l = col / 3072, e = col - l * 3072;
        const float* wp = p.ada_w + (size_t)l * 1024 * 3072 + e;
        float a0 = 0, a1 = 0, a2 = 0, a3 = 0, a4 = 0;
        for (int d = q * 256; d < q * 256 + 256; ++d) {
          const float wv = wp[(size_t)d * 3072];
          a0 += scond[d] * wv; a1 += scond[1024 + d] * wv; a2 += scond[2048 + d] * wv;
          a3 += scond[3072 + d] * wv; a4 += scond[4096 + d] * wv;
        }
        red[(q * 5 + 0) * 64 + (tid & 63)] = a0; red[(q * 5 + 1) * 64 + (tid & 63)] = a1;
        red[(q * 5 + 2) * 64 + (tid & 63)] = a2; red[(q * 5 + 3) * 64 + (tid & 63)] = a3;
        red[(q * 5 + 4) * 64 + (tid & 63)] = a4;
        __syncthreads();
        for (int idx = tid; idx < 320; idx += 256) {
          const int rr = idx >> 6, cc = idx & 63;
          const float s = red[(0 * 5 + rr) * 64 + cc] + red[(1 * 5 + rr) * 64 + cc] + red[(2 * 5 + rr) * 64 + cc] + red[(3 * 5 + rr) * 64 + cc];
          const int col2 = it * 64 + cc, l2 = col2 / 3072, e2 = col2 - l2 * 3072;
          MOD[((size_t)l2 * 5 + rr) * 3072 + e2] = s + p.ada_b[l2 * 3072 + e2];
        }
        __syncthreads();
      } else {
        int t = it - N_ADA;
        const float* W; h16* Wt; int K, N, Npad; const float* gk = nullptr;
        if (t < 2 * T_EV) { int i = t / T_EV; t -= i * T_EV; W = p.ev_w_in + (size_t)i * 1024 * EV_IN; Wt = WEV + (size_t)i * EV_INP * 1024; K = 1024; N = EV_IN; Npad = EV_INP; }
        else if ((t -= 2 * T_EV) < 2 * T_OD) { int i = t / T_OD; t -= i * T_OD; W = p.od_w_in + (size_t)i * 1024 * OD_IN; Wt = WOD + (size_t)i * OD_INP * 1024; K = 1024; N = OD_IN; Npad = OD_INP; }
        else if ((t -= 2 * T_OD) < 4 * T_OUT) { int l = t / T_OUT; t -= l * T_OUT; W = ((l & 1) ? p.od_w_out : p.ev_w_out) + (size_t)(l >> 1) * 1024 * 1024; Wt = WOUT + (size_t)l * 1024 * 1024; K = 1024; N = 1024; Npad = 1024; }
        else if ((t -= 4 * T_OUT) < 2 * T_UQ) { int i = t / T_UQ; t -= i * T_UQ; W = p.mla_w_uq + (size_t)i * 256 * 768; Wt = WUQ + (size_t)i * 768 * 256; K = 256; N = 768; Npad = 768; gk = p.mla_q_norm_g + i * 256; }
        else { t -= 2 * T_UQ; int i = t / T_UKV; t -= i * T_UKV; W = p.mla_w_ukv + (size_t)i * 128 * 1024; Wt = WUKV + (size_t)i * 1024 * 128; K = 128; N = 1024; Npad = 1024; gk = p.mla_kv_norm_g + i * 128; }
        const int nK = K >> 6;
        const int kt = t % nK, nt = t / nK, k0 = kt * 64, n0 = nt * 64;
        const int cc = tid & 63, r4 = tid >> 6;
#pragma unroll 4
        for (int i = 0; i < 16; ++i) {
          const int rr = r4 + 4 * i, n = n0 + cc;
          float v = 0.f;
          if (n < N) { v = W[(size_t)(k0 + rr) * N + n]; if (gk) v *= gk[k0 + rr]; }
          lds[rr * 65 + cc] = v;
        }
        __syncthreads();
#pragma unroll 4
        for (int i = 0; i < 16; ++i) {
          const int rr = r4 + 4 * i;
          Wt[(size_t)(n0 + rr) * K + k0 + cc] = (h16)lds[cc * 65 + rr];
        }
        __syncthreads();
      }
    }
    for (int idx = bid * 256 + tid; idx < SEQ * 48; idx += nblk * 256) {
      const int s = idx / 48, i = idx - s * 48;
      const int grow = s >> 6, gcol = s & 63;
      float ang;
      float* dst;
      if (i < 32) {
        const int f = i & 15;
        const float fr = expf(-(float)f * (9.210340371976184f / 16.f));
        ang = (float)(i < 16 ? grow : gcol) * fr;
        dst = RDA + ((size_t)s * 32 + i) * 2;
      } else {
        const int ii = i - 32, f = ii & 7;
        const float fr = expf(-(float)f * (9.210340371976184f / 8.f));
        ang = (float)(ii < 8 ? grow : gcol) * fr;
        dst = RML + ((size_t)s * 16 + ii) * 2;
      }
      const float kf = rintf(ang * 0.15915494309189535f);
      float rr = fmaf(-kf, 6.28125f, ang);
      rr = fmaf(-kf, 1.9353071795864769e-3f, rr);
      dst[0] = cosf(rr);
      dst[1] = sinf(rr);
    }
  }
  grid.sync();
  const XcdBarrier xb = xcd_barrier_post(xbar, (volatile LAS unsigned*)&xb_words);
#ifdef NSYNC_EXTRA
  for (int i_ = 0; i_ < NSYNC_EXTRA; ++i_) xcd_barrier(xb);
#endif
  for (int idx = bid * 256 + tid; idx < NR * 128; idx += nblk * 256) {
    const int R = idx >> 7, c8 = (idx & 127) * 8;
    const int b = R / TB, j = R - b * TB;
    const float* xr = in_row(p, R) + c8;
    const float* md = MOD + (size_t)(j < SEQ ? b : 4) * 3072;
    const float4 x0 = *(const float4*)xr, x1 = *(const float4*)(xr + 4);
    const float4 s0 = *(const float4*)(md + c8), s1 = *(const float4*)(md + c8 + 4);
    const float4 c0 = *(const float4*)(md + 1024 + c8), c1 = *(const float4*)(md + 1024 + c8 + 4);
    h8 o;
    o[0] = (h16)(x0.x * (1.f + c0.x) + s0.x); o[1] = (h16)(x0.y * (1.f + c0.y) + s0.y);
    o[2] = (h16)(x0.z * (1.f + c0.z) + s0.z); o[3] = (h16)(x0.w * (1.f + c0.w) + s0.w);
    o[4] = (h16)(x1.x * (1.f + c1.x) + s1.x); o[5] = (h16)(x1.y * (1.f + c1.y) + s1.y);
    o[6] = (h16)(x1.z * (1.f + c1.z) + s1.z); o[7] = (h16)(x1.w * (1.f + c1.w) + s1.w);
    *(h8*)(H + (size_t)R * 1024 + c8) = o;
  }
  xcd_barrier(xb);

#pragma unroll 1
  for (int layer = 0; layer < 4; ++layer) {
    asm volatile("" : "+s"(ws));
    h16* WEV = (h16*)(ws + OFF_WEV);
    h16* WOD = (h16*)(ws + OFF_WOD);
    h16* WOUT = (h16*)(ws + OFF_WOUT);
    h16* WUQ = (h16*)(ws + OFF_WUQ);
    h16* WUKV = (h16*)(ws + OFF_WUKV);
    float* MOD = (float*)(ws + OFF_MOD);
    float* RDA = (float*)(ws + OFF_RDA);
    float* RML = (float*)(ws + OFF_RML);
    h16* X16 = (h16*)(ws + OFF_X16);
    h16* GY = (h16*)(ws + OFF_GY);
    h16* H = (h16*)(ws + OFF_H);
    h16* T = (h16*)(ws + OFF_T);
    const int li_ = layer >> 1;
    const bool upd = layer < 3;
    if ((layer & 1) == 0) {
      {
        EpiEven epi{p.ev_b_in + (size_t)li_ * EV_IN, RDA, RML, (h16*)(ws + OFF_QK4), (h16*)(ws + OFF_VT),
                    (h16*)(ws + OFF_CQKV), (h16*)(ws + OFF_KR), GY};
        const h16* Bt = WEV + (size_t)li_ * EV_INP * 1024;
        constexpr int NT = EV_INP / 128;
        constexpr int NTW = NT / 2;
        for (int it = bid; it < 264 * NTW; it += nblk) {
          const int x = it & 7, q = it >> 3;
          const int mt = 33 * x + q / NTW, nt = q % NTW;
          gemm_tile_w(H, 1024, Bt, 1024, 1024, mt * 128, nt * 256, smem, epi);
        }
      }
      xcd_barrier(xb);
      {
        int tid = threadIdx.x; asm volatile("" : "+v"(tid)); const int lane = tid & 63, w = tid >> 6; (void)lane; (void)w;
        const h16* CQKV = (const h16*)(ws + OFF_CQKV);
        float* rstd = (float*)(smem + 73728);
#pragma unroll 1
        for (int rep_ = 0; rep_ < NREP_GEMM; ++rep_)
        for (int it = bid; it < 264 * 14; it += nblk) {
          const int mt = it / 14, nt = it - mt * 14;
          const int row0 = mt * 128;
          const bool uq = nt < 6;
          {
            const int rr = tid >> 1, hs = tid & 1;
            const h16* src = CQKV + (size_t)(row0 + rr) * 384 + (uq ? hs * 128 : 256 + hs * 64);
            float ss = 0.f;
            const int n8 = uq ? 16 : 8;
            for (int q = 0; q < n8; ++q) {
              const h8 v = *(const h8*)(src + q * 8);
#pragma unroll
              for (int e = 0; e < 8; ++e) ss += (float)v[e] * (float)v[e];
            }
            ss += __shfl_xor(ss, 1);
            if (hs == 0) rstd[rr] = rsqrtf(ss * (uq ? 1.f / 256.f : 1.f / 128.f) + 1e-6f);
          }
          __syncthreads();
          if (uq) {
            EpiUQ epi{rstd, row0, RML, (h16*)(ws + OFF_QM)};
            gemm_tile(CQKV, 384, WUQ + (size_t)li_ * 768 * 256, 256, 256, row0, nt * 128, smem, epi);
          } else {
            EpiUKV epi{rstd, row0, (h16*)(ws + OFF_KN), (h16*)(ws + OFF_VMT)};
            gemm_tile(CQKV + 256, 384, WUKV + (size_t)li_ * 1024 * 128, 128, 128, row0, (nt - 6) * 128, smem, epi);
          }
          __syncthreads();
        }
      }
      xcd_barrier(xb);
      {
        int tid = threadIdx.x; asm volatile("" : "+v"(tid)); const int lane = tid & 63, w = tid >> 6; (void)lane; (void)w;
        const float lam_init = 0.8f - 0.6f * expf(-0.3f * (float)layer);
        float lam;
        {
          const float* dl = p.da_lambda + (size_t)li_ * 256;
          float s1 = dl[lane] * dl[64 + lane], s2 = dl[128 + lane] * dl[192 + lane];
#pragma unroll
          for (int off = 32; off > 0; off >>= 1) { s1 += __shfl_xor(s1, off); s2 += __shfl_xor(s2, off); }
          lam = expf(s1) - expf(s2) + lam_init;
        }
        constexpr int N_DA = 1024, N_MLA = 1024, N_DAC = 32, N_MLAC = 32;
#ifndef NREP_E4
#define NREP_E4 1
#endif
#pragma unroll 1
        for (int rep = 0; rep < NREP_E4; ++rep) {
        int dry = (rep + 1 < NREP_E4); asm volatile("" : "+s"(dry));
        for (int it = bid; it < N_DA + N_MLA + N_DAC + N_MLAC; it += nblk) {
          if (it < N_DA) {
            const int rd = it >> 9, pair = rd * 8 + (it & 7), qt = (it & 511) >> 3, hd = pair & 3, b = pair >> 2;

#ifndef SKIP_DA
            da_item(p, layer, b, hd, qt * 128, 0, 132, lam, lam_init, smem, dry);
#endif

          } else if (it < N_DA + N_MLA) {
            const int t = it - N_DA;
            const int rd = t >> 9, x = t & 7, slot = (t & 511) >> 3;
            const int pair = rd * 16 + x * 2 + (slot >> 5), qt = slot & 31, hd = pair & 7, b = pair >> 3;

#ifndef SKIP_MLA
            mla_item(p, b, hd, qt * 256, 0, 132, smem, dry);
#endif

          } else if (it < N_DA + N_MLA + N_DAC) {
            const int t = it - N_DA - N_MLA;
            const int qt = t & 1, hd = (t >> 1) & 3, b = t >> 3;

#ifndef SKIP_DA
            da_item(p, layer, b, hd, SEQ + qt * 128, 128, 132, lam, lam_init, smem, dry);
#endif

          } else {
            const int t = it - N_DA - N_MLA - N_DAC;
            const int hd = t & 7, b = t >> 3;

#ifndef SKIP_MLA
            mla_item(p, b, hd, SEQ, 128, 132, smem, dry);
#endif

          }
        }
        }
      }
      xcd_barrier(xb);

    } else {
      {
        EpiOdd epi{p.od_b_in + (size_t)li_ * OD_IN, (h16*)(ws + OFF_QKP), (h16*)(ws + OFF_MVT), (h16*)(ws + OFF_OG),
                   (h16*)(ws + OFF_NAQ), (h16*)(ws + OFF_NAK), (h16*)(ws + OFF_NAVT), GY, (float*)(ws + OFF_GT)};
        const h16* Bt = WOD + (size_t)li_ * OD_INP * 1024;
        constexpr int NT = OD_INP / 128;
        constexpr int NTW = NT / 2;
        for (int it = bid; it < 264 * NTW; it += nblk) {
          const int x = it & 7, q = it >> 3;
          const int mt = 33 * x + q / NTW, nt = q % NTW;
          gemm_tile_w(H, 1024, Bt, 1024, 1024, mt * 128, nt * 256, smem, epi);
        }
      }
      xcd_barrier(xb);
      {
        int tid = threadIdx.x; asm volatile("" : "+v"(tid)); const int lane = tid & 63, w = tid >> 6; (void)lane; (void)w;
        constexpr int N_M1 = NCHAIN * NCHUNK, N_NA = 4 * 128 * 4;
        const int n_nac = upd ? 64 : 0;
#ifndef NREP_O2
#define NREP_O2 1
#endif
#pragma unroll 1
        for (int rep = 0; rep < NREP_O2; ++rep) {
        int dry = (rep + 1 < NREP_O2); asm volatile("" : "+s"(dry));
        constexpr int N_NA_O2 = 448;
        for (int it = bid; it < N_M1 + N_NA_O2; it += nblk) {
          if (it < N_M1) {

#ifndef SKIP_M1
            m1_item(p, layer, it / NCHUNK, it % NCHUNK, smem);
#endif

          } else {
            const int t = it - N_M1;
            const int hp = t & 3, gr = (t >> 2) & 127, b = t >> 9;

#ifndef SKIP_NA
            na_wave(p, layer, b, gr, hp, smem, dry);
#endif

          }
        }
        }
        (void)N_NA; (void)n_nac;
      }
      xcd_barrier(xb);
      {
        int tid = threadIdx.x; asm volatile("" : "+v"(tid)); const int lane = tid & 63, w = tid >> 6; (void)lane; (void)w;
        h16* UT = (h16*)(ws + OFF_H);
        const float* BT = (const float*)(ws + OFF_BT);
        const float* GM = (const float*)(ws + OFF_GM);
        float* MP = (float*)(ws + OFF_MP);
        float* NL = (float*)(ws + OFF_NL);
        for (int idx = bid * 256 + tid; idx < NCHAIN * 4096 + NCHAIN * 128; idx += nblk * 256) {
          if (idx < NCHAIN * 4096) {
            const int c = idx >> 12, e = (idx & 4095) * 4;
            float m = 0.f, C0 = 0.f, C1 = 0.f, C2 = 0.f, C3 = 0.f;
            h16* ub = UT + (size_t)c * NCHUNK * 16384 + e;
#pragma unroll 1
            for (int k0 = 0; k0 < NCHUNK; k0 += 6) {
              h4 u[6];
#pragma unroll
              for (int j = 0; j < 6; ++j) u[j] = *(const h4*)(ub + (size_t)(k0 + j) * 16384);
#pragma unroll
              for (int j = 0; j < 6; ++j) {
                const int k = k0 + j;
                const float bt = BT[c * NCHUNK + k], gm = GM[c * NCHUNK + k];
                const float mn = fmaxf(bt + m, gm);
                const float decay = __expf(bt + m - mn), sc = __expf(gm - mn);
                h4 cv; cv[0] = (h16)C0; cv[1] = (h16)C1; cv[2] = (h16)C2; cv[3] = (h16)C3;
                *(h4*)(ub + (size_t)k * 16384) = cv;
                if (e == 0) MP[c * NCHUNK + k] = m;
                C0 = decay * C0 + sc * (float)u[j][0]; C1 = decay * C1 + sc * (float)u[j][1];
                C2 = decay * C2 + sc * (float)u[j][2]; C3 = decay * C3 + sc * (float)u[j][3];
                m = mn;
              }
            }
          } else {
            const int q = idx - NCHAIN * 4096;
            const int c = q >> 7, e = q & 127;
            float m = 0.f, C = 0.f;
            float* nb = NL + (size_t)c * NCHUNK * 128 + e;
#pragma unroll 1
            for (int k0 = 0; k0 < NCHUNK; k0 += 6) {
              float u[6];
#pragma unroll
              for (int j = 0; j < 6; ++j) u[j] = nb[(k0 + j) * 128];
#pragma unroll
              for (int j = 0; j < 6; ++j) {
                const int k = k0 + j;
                const float bt = BT[c * NCHUNK + k], gm = GM[c * NCHUNK + k];
                const float mn = fmaxf(bt + m, gm);
                const float decay = __expf(bt + m - mn), sc = __expf(gm - mn);
                nb[k * 128] = C;
                C = decay * C + sc * u[j];
                m = mn;
              }
            }
          }
        }
      }
      xcd_barrier(xb);
      {
        const int nkc = upd ? 66 : 64;
#ifndef NREP_M3
#define NREP_M3 1
#endif
#pragma unroll 1
        for (int rep = 0; rep < NREP_M3; ++rep) {
        int dry = (rep + 1 < NREP_M3); asm volatile("" : "+s"(dry));
        for (int it = bid; it < 16 * nkc; it += nblk) {
          const int kc = it % nkc, bh = it / nkc;

#ifndef SKIP_M3
          m3_item(p, layer, bh >> 2, bh & 3, kc, smem, dry);
#endif

        }
        {
          int tid = threadIdx.x; asm volatile("" : "+v"(tid)); const int w = tid >> 6;
          const int n_rest = (2048 - 448) + (upd ? 64 : 0);
          const int nskip = (upd && nblk > 64) ? 32 : 0;
          for (int j = (bid >= nskip ? bid - nskip : n_rest); j < n_rest; j += nblk - nskip) {
            if (j < 2048 - 448) {
              const int t = 448 + j;
              const int hp = t & 3, gr = (t >> 2) & 127, b = t >> 9;
              na_wave(p, layer, b, gr, hp, smem, dry);
            } else {
              const int t = j - (2048 - 448);
              nactx_item(p, t >> 4, (t >> 1) & 7, t & 1, dry);
            }
          }
        }
        }
      }
      xcd_barrier(xb);
    }
    {
      EpiOut epi{p.x, p.ctx, layer, MOD, X16, T};
      const h16* Bt = WOUT + (size_t)layer * 1024 * 1024;
#pragma unroll 1
      for (int rep_ = 0; rep_ < NREP_GEMM; ++rep_)
      for (int it = bid; it < 5 * 512; it += nblk) {
        const int sup = (it >> 9) * 8 + (it & 7), slot = (it & 511) >> 3;
        if (sup >= 33) continue;
        const int mt = sup * 8 + (slot >> 3), nt = slot & 7;
        if (!upd && (mt % 66) >= 64) continue;
        gemm_tile(GY, 1024, Bt, 1024, 1024, mt * 128, nt * 128, smem, epi);
      }
    }
    xcd_barrier(xb);
    {
      int tid2 = threadIdx.x; asm volatile("" : "+v"(tid2));
      const int lane = tid2 & 63, w = tid2 >> 6;
      const float* lg = p.ln_g + layer * 1024;
      const float* lb = p.ln_b + layer * 1024;
      for (int R = bid * 4 + w; R < NR; R += nblk * 4) {
        const int b = R / TB, j = R - b * TB;
        if (!upd && j >= SEQ) continue;
        const h16* tr = T + (size_t)R * 1024;
        float4 v[4];
        float s = 0.f;
#pragma unroll
        for (int q = 0; q < 4; ++q) {
          const h4 th = *(const h4*)(tr + q * 256 + lane * 4);
          v[q].x = (float)th[0]; v[q].y = (float)th[1]; v[q].z = (float)th[2]; v[q].w = (float)th[3];
          s += v[q].x + v[q].y + v[q].z + v[q].w;
        }
#pragma unroll
        for (int off = 32; off > 0; off >>= 1) s += __shfl_xor(s, off);
        const float mu = s * (1.f / 1024.f);
        float vs = 0.f;
#pragma unroll
        for (int q = 0; q < 4; ++q) {
          v[q].x -= mu; v[q].y -= mu; v[q].z -= mu; v[q].w -= mu;
          vs += v[q].x * v[q].x + v[q].y * v[q].y + v[q].z * v[q].z + v[q].w * v[q].w;
        }
#pragma unroll
        for (int off = 32; off > 0; off >>= 1) vs += __shfl_xor(vs, off);
        const float rstd = rsqrtf(vs * (1.f / 1024.f) + 1e-5f);
        const float* md = MOD + ((size_t)(layer + 1) * 5 + (j < SEQ ? b : 4)) * 3072;
#pragma unroll
        for (int q = 0; q < 4; ++q) {
          const int col = q * 256 + lane * 4;
          const float4 g4 = *(const float4*)(lg + col), b4 = *(const float4*)(lb + col);
          float4 xo;
          xo.x = v[q].x * rstd * g4.x + b4.x; xo.y = v[q].y * rstd * g4.y + b4.y;
          xo.z = v[q].z * rstd * g4.z + b4.z; xo.w = v[q].w * rstd * g4.w + b4.w;
          if (upd) {
            h4 xh; xh[0] = (h16)xo.x; xh[1] = (h16)xo.y; xh[2] = (h16)xo.z; xh[3] = (h16)xo.w;
            *(h4*)(X16 + (size_t)R * 1024 + col) = xh;
            const float4 sh = *(const float4*)(md + col), sc = *(const float4*)(md + 1024 + col);
            h4 hh4;
            hh4[0] = (h16)(xo.x * (1.f + sc.x) + sh.x); hh4[1] = (h16)(xo.y * (1.f + sc.y) + sh.y);
            hh4[2] = (h16)(xo.z * (1.f + sc.z) + sh.z); hh4[3] = (h16)(xo.w * (1.f + sc.w) + sh.w);
            *(h4*)(H + (size_t)R * 1024 + col) = hh4;
          } else {
            *(float4*)(p.out + ((size_t)b * SEQ + j) * 1024 + col) = xo;
          }
        }
      }
    }
    if (layer < 3) xcd_barrier(xb);
  }
}

extern "C" void kernel_launch(void* const* d_in, const int* in_sizes, int n_in, void* d_out, int out_size, void* d_ws,
                              size_t ws_size, hipStream_t stream) {
  static int grid_blocks = 0;
  if (!grid_blocks) {
    int dev = 0, cus = 0, per_cu = 0;
    hipGetDevice(&dev);
    hipDeviceGetAttribute(&cus, hipDeviceAttributeMultiprocessorCount, dev);
    hipOccupancyMaxActiveBlocksPerMultiprocessor(&per_cu, fwd_megakernel, 256, 0);
    if (per_cu > 2) per_cu = 2;
    if (per_cu < 1) per_cu = 1;
    grid_blocks = cus * per_cu;
  }
  Params p{};
  const float** pp = (const float**)&p;
  for (int i = 0; i < 25; ++i) pp[i] = (const float*)d_in[i];
  p.out = (float*)d_out;
  p.ws = (char*)d_ws;
  void* args[] = {&p};
  hipError_t e = hipLaunchCooperativeKernel((void*)fwd_megakernel, dim3(grid_blocks), dim3(256), args, 0, stream);
  if (e != hipSuccess) fprintf(stderr, "cooperative launch failed: %s (grid %d)\n", hipGetErrorString(e), grid_blocks);
}
```

```cpp
#include <hip/hip_runtime.h>
#include <hip/hip_cooperative_groups.h>
#include <cstdio>
namespace cg = cooperative_groups;

typedef _Float16 h16;
typedef __attribute__((ext_vector_type(8))) _Float16 h8;
typedef __attribute__((ext_vector_type(4))) _Float16 h4;
typedef __attribute__((ext_vector_type(16))) float f16v;
#define MFMA(a, b, c) __builtin_amdgcn_mfma_f32_32x32x16_f16((a), (b), (c), 0, 0, 0)
#define DI __device__ __forceinline__

constexpr int NB = 4, SEQ = 8192, CTXL = 256, TB = 8448, NR = NB * TB, DM = 1024;
constexpr int EV_IN = 2976, EV_INP = 3072, OD_IN = 4624, OD_INP = 4864;
constexpr int NCHAIN = 32, NCHUNK = 66;
constexpr float LOG2E = 1.4426950408889634f;
constexpr float DN_ALPHA = 1.681792830507429f;

constexpr size_t al256(size_t x) { return (x + 255) & ~(size_t)255; }
constexpr size_t OFF_WEV = 0;
constexpr size_t OFF_WOD = OFF_WEV + al256(2ull * EV_INP * 1024 * 2);
constexpr size_t OFF_WOUT = OFF_WOD + al256(2ull * OD_INP * 1024 * 2);
constexpr size_t OFF_WUQ = OFF_WOUT + al256(4ull * 1024 * 1024 * 2);
constexpr size_t OFF_WUKV = OFF_WUQ + al256(2ull * 768 * 256 * 2);
constexpr size_t OFF_MOD = OFF_WUKV + al256(2ull * 1024 * 128 * 2);
constexpr size_t OFF_RDA = OFF_MOD + al256(4ull * 5 * 3072 * 4);
constexpr size_t OFF_RML = OFF_RDA + al256(8192ull * 32 * 2 * 4);
constexpr size_t OFF_BT = OFF_RML + al256(8192ull * 16 * 2 * 4);
constexpr size_t OFF_GM = OFF_BT + al256(NCHAIN * NCHUNK * 4);
constexpr size_t OFF_MP = OFF_GM + al256(NCHAIN * NCHUNK * 4);
constexpr size_t OFF_NL = OFF_MP + al256(NCHAIN * NCHUNK * 4);
constexpr size_t OFF_BAR = OFF_NL + al256((size_t)NCHAIN * NCHUNK * 128 * 4);
constexpr size_t OFF_X16 = OFF_BAR + 16384;
constexpr size_t SZ_ACT = (size_t)NR * 1024 * 2;
constexpr size_t OFF_GY = OFF_X16 + SZ_ACT;
constexpr size_t OFF_H = OFF_GY + SZ_ACT;
constexpr size_t OFF_SCR = OFF_H + SZ_ACT;
constexpr size_t OFF_T = OFF_SCR;
constexpr size_t OFF_QK4 = OFF_SCR;
constexpr size_t OFF_VT = OFF_QK4 + SZ_ACT;
constexpr size_t OFF_CQKV = OFF_VT + (size_t)NB * 512 * TB * 2;
constexpr size_t OFF_KR = OFF_CQKV + (size_t)NR * 384 * 2;
constexpr size_t OFF_QM = OFF_KR + (size_t)NR * 32 * 2;
constexpr size_t OFF_KN = OFF_QM + (size_t)NR * 768 * 2;
constexpr size_t OFF_VMT = OFF_KN + (size_t)NR * 512 * 2;
constexpr size_t END_EVEN = OFF_VMT + (size_t)NB * 512 * TB * 2;
constexpr size_t OFF_QKP = OFF_SCR;
constexpr size_t OFF_MVT = OFF_QKP + SZ_ACT;
constexpr size_t OFF_OG = OFF_MVT + (size_t)NB * 512 * TB * 2;
constexpr size_t OFF_NAQ = OFF_OG + (size_t)NR * 512 * 2;
constexpr size_t OFF_NAK = OFF_NAQ + (size_t)NR * 512 * 2;
constexpr size_t OFF_NAVT = OFF_NAK + (size_t)NR * 512 * 2;
constexpr size_t OFF_GT = OFF_NAVT + (size_t)NB * 512 * TB * 2;
constexpr size_t END_ODD = OFF_GT + (size_t)NR * 16 * 4;
constexpr size_t WS_NEED = END_EVEN > END_ODD ? END_EVEN : END_ODD;
static_assert(WS_NEED <= 536870912ull, "workspace too big");
static_assert(OFF_QKP + SZ_ACT + 2 * (size_t)NB * 512 * TB * 2 >= OFF_T + (size_t)NR * 1024 * 4, "T alias odd");

#ifndef NREP_GEMM
#define NREP_GEMM 1
#endif
struct Params {
  const float *x, *c, *ctx, *c_ctx, *ada_w, *ada_b, *ln_g, *ln_b, *ev_w_in, *ev_b_in, *da_lambda, *da_subln_g,
      *mla_q_norm_g, *mla_kv_norm_g, *mla_w_uq, *mla_w_ukv, *ev_w_out, *od_w_in, *od_b_in, *ml_conv_w, *ml_conv_b,
      *ml_f_bias, *ml_norm_g, *na_rpb, *od_w_out;
  float* out;
  char* ws;
};

DI int crow(int i, int hh) { return (i & 3) + 8 * (i >> 2) + 4 * hh; }
DI float silu_f(float v) { return v / (1.f + __expf(-v)); }
DI float sigmoid_f(float v) { return 1.f / (1.f + __expf(-v)); }
DI float logsig_f(float v) { return fminf(v, 0.f) - log1pf(__expf(-fabsf(v))); }
DI float xhalf_max(float x) {
  const unsigned u = __float_as_uint(x);
  auto rr = __builtin_amdgcn_permlane32_swap(u, u, false, false);
  return fmaxf(__uint_as_float(rr[0]), __uint_as_float(rr[1]));
}
DI float xhalf_sum(float x) {
  const unsigned u = __float_as_uint(x);
  auto rr = __builtin_amdgcn_permlane32_swap(u, u, false, false);
  return __uint_as_float(rr[0]) + __uint_as_float(rr[1]);
}
DI h8 cat44(h4 a, h4 b) { return __builtin_shufflevector(a, b, 0, 1, 2, 3, 4, 5, 6, 7); }
DI f16v zero16() { f16v z;
#pragma unroll
  for (int i = 0; i < 16; ++i) z[i] = 0.f; return z; }

DI const float* in_row(const Params& p, int R) {
  int b = R / TB, j = R - b * TB;
  return j < SEQ ? p.x + ((size_t)b * SEQ + j) * DM : p.ctx + ((size_t)b * CTXL + (j - SEQ)) * DM;
}

template <class Epi>
DI void gemm_tile(const h16* __restrict__ A, int lda, const h16* __restrict__ Bt, int ldb, int K, int row0, int col0,
                  char* smem, const Epi& epi) {
  h16* As = (h16*)smem;
  h16* Bs = As + 128 * 72;
  int tid = threadIdx.x; asm volatile("" : "+v"(tid));
  const int lane = tid & 63, w = tid >> 6, wm = w >> 1, wn = w & 1, r = lane & 31, hh = lane >> 5;
  f16v acc00 = zero16(), acc01 = zero16(), acc10 = zero16(), acc11 = zero16();
  const int lr = tid >> 3, lc = (tid & 7) * 8;
  const h16* Ap = A + (size_t)(row0 + lr) * lda + lc;
  const h16* Bp = Bt + (size_t)(col0 + lr) * ldb + lc;
  const size_t sa = (size_t)32 * lda, sb = (size_t)32 * ldb;
  uint4 ra0, ra1, ra2, ra3, rb0, rb1, rb2, rb3;
  uint4 sa0, sa1, sa2, sa3, sb0, sb1, sb2, sb3;
#define GLOAD(K0)                                                                                   \
  ra0 = *(const uint4*)(Ap + (K0)); ra1 = *(const uint4*)(Ap + sa + (K0));                          \
  ra2 = *(const uint4*)(Ap + 2 * sa + (K0)); ra3 = *(const uint4*)(Ap + 3 * sa + (K0));             \
  rb0 = *(const uint4*)(Bp + (K0)); rb1 = *(const uint4*)(Bp + sb + (K0));                          \
  rb2 = *(const uint4*)(Bp + 2 * sb + (K0)); rb3 = *(const uint4*)(Bp + 3 * sb + (K0));
#define GLOADB(K0)                                                                                  \
  sa0 = *(const uint4*)(Ap + (K0)); sa1 = *(const uint4*)(Ap + sa + (K0));                          \
  sa2 = *(const uint4*)(Ap + 2 * sa + (K0)); sa3 = *(const uint4*)(Ap + 3 * sa + (K0));             \
  sb0 = *(const uint4*)(Bp + (K0)); sb1 = *(const uint4*)(Bp + sb + (K0));                          \
  sb2 = *(const uint4*)(Bp + 2 * sb + (K0)); sb3 = *(const uint4*)(Bp + 3 * sb + (K0));
#define SWRITE(ST)                                                                                  \
  { h16* as_ = As + (ST) * 18432 + lr * 72 + lc; h16* bs_ = Bs + (ST) * 18432 + lr * 72 + lc;       \
  *(uint4*)(as_) = ra0; *(uint4*)(as_ + 32 * 72) = ra1;                                             \
  *(uint4*)(as_ + 64 * 72) = ra2; *(uint4*)(as_ + 96 * 72) = ra3;                                   \
  *(uint4*)(bs_) = rb0; *(uint4*)(bs_ + 32 * 72) = rb1;                                             \
  *(uint4*)(bs_ + 64 * 72) = rb2; *(uint4*)(bs_ + 96 * 72) = rb3; }
#define SWRITEB(ST)                                                                                 \
  { h16* as_ = As + (ST) * 18432 + lr * 72 + lc; h16* bs_ = Bs + (ST) * 18432 + lr * 72 + lc;       \
  *(uint4*)(as_) = sa0; *(uint4*)(as_ + 32 * 72) = sa1;                                             \
  *(uint4*)(as_ + 64 * 72) = sa2; *(uint4*)(as_ + 96 * 72) = sa3;                                   \
  *(uint4*)(bs_) = sb0; *(uint4*)(bs_ + 32 * 72) = sb1;                                             \
  *(uint4*)(bs_ + 64 * 72) = sb2; *(uint4*)(bs_ + 96 * 72) = sb3; }
#define GCOMPUTE(ST)                                                                                \
  { const h16* Ac = As + (ST) * 18432; const h16* Bc = Bs + (ST) * 18432;                           \
    _Pragma("unroll") for (int kk = 0; kk < 4; ++kk) {                                              \
      h8 a0 = *(const h8*)(Ac + (wm * 64 + r) * 72 + kk * 16 + hh * 8);                             \
      h8 a1 = *(const h8*)(Ac + (wm * 64 + 32 + r) * 72 + kk * 16 + hh * 8);                        \
      h8 b0 = *(const h8*)(Bc + (wn * 64 + r) * 72 + kk * 16 + hh * 8);                             \
      h8 b1 = *(const h8*)(Bc + (wn * 64 + 32 + r) * 72 + kk * 16 + hh * 8);                        \
      acc00 = MFMA(a0, b0, acc00); acc01 = MFMA(a0, b1, acc01);                                     \
      acc10 = MFMA(a1, b0, acc10); acc11 = MFMA(a1, b1, acc11); } }
  GLOAD(0)
  SWRITE(0)
  __syncthreads();
  GLOAD(64)
  if (128 < K) { GLOADB(128) }
#pragma unroll 1
  for (int k0 = 0; k0 < K; k0 += 128) {
    SWRITE(1)
    if (k0 + 192 < K) { GLOAD(k0 + 192) }
    GCOMPUTE(0)
    __syncthreads();
    if (k0 + 128 < K) {
      SWRITEB(0)
      if (k0 + 256 < K) { GLOADB(k0 + 256) }
    }
    GCOMPUTE(1)
    __syncthreads();
  }
#undef GLOADB
#undef SWRITEB
#undef GCOMPUTE
#undef GLOAD
#undef SWRITE
  epi.frag(smem, row0 + wm * 64, col0 + wn * 64, wm * 64, wn * 64, acc00, acc01);
  epi.frag(smem, row0 + wm * 64 + 32, col0 + wn * 64, wm * 64 + 32, wn * 64, acc10, acc11);
  __syncthreads();
  epi.copy(smem, row0, col0);
  __syncthreads();
}

constexpr int STG_T_OFF = 34816;
template <class Epi>
DI void gemm_tile_w(const h16* __restrict__ A, int lda, const h16* __restrict__ Bt, int ldb, int K, int row0, int col0,
                    char* smem, const Epi& epi) {
  h16* As = (h16*)smem;
  h16* Bs = As + 128 * 40;
  int tid = threadIdx.x; asm volatile("" : "+v"(tid));
  const int lane = tid & 63, w = tid >> 6, wm = w >> 1, wn = w & 1, r = lane & 31, hh = lane >> 5;
  f16v acc[2][4];
#pragma unroll
  for (int i = 0; i < 2; ++i)
#pragma unroll
    for (int j = 0; j < 4; ++j) acc[i][j] = zero16();
  const int lr = tid >> 2, lc = (tid & 3) * 8;
  const h16* Ap = A + (size_t)(row0 + lr) * lda + lc;
  const h16* Bp = Bt + (size_t)(col0 + lr) * ldb + lc;
  const size_t sa = (size_t)64 * lda, sb = (size_t)64 * ldb;
  uint4 ra0, ra1, rb0, rb1, rb2, rb3;
#define WLOAD(K0) ra0 = *(const uint4*)(Ap + (K0)); ra1 = *(const uint4*)(Ap + sa + (K0));                       \
  rb0 = *(const uint4*)(Bp + (K0)); rb1 = *(const uint4*)(Bp + sb + (K0));                                        \
  rb2 = *(const uint4*)(Bp + 2 * sb + (K0)); rb3 = *(const uint4*)(Bp + 3 * sb + (K0));
#define WWRITE(ST) { h16* as_ = As + (ST) * 15360 + lr * 40 + lc; h16* bs_ = Bs + (ST) * 15360 + lr * 40 + lc;   \
  *(uint4*)(as_) = ra0; *(uint4*)(as_ + 64 * 40) = ra1;                                                           \
  *(uint4*)(bs_) = rb0; *(uint4*)(bs_ + 64 * 40) = rb1; *(uint4*)(bs_ + 128 * 40) = rb2; *(uint4*)(bs_ + 192 * 40) = rb3; }
  WLOAD(0)
  WWRITE(0)
  __syncthreads();
  WLOAD(32)
#pragma unroll 1
  for (int k0 = 0; k0 < K; k0 += 32) {
    const int st = (k0 >> 5) & 1;
    if (k0 + 32 < K) {
      WWRITE(st ^ 1)
      if (k0 + 64 < K) { WLOAD(k0 + 64) }
    }
    const h16* Ac = As + st * 15360 + (wm * 64 + r) * 40 + hh * 8;
    const h16* Bc = Bs + st * 15360 + (wn * 128 + r) * 40 + hh * 8;
#pragma unroll
    for (int kk = 0; kk < 2; ++kk) {
      const h8 a0 = *(const h8*)(Ac + kk * 16), a1 = *(const h8*)(Ac + 32 * 40 + kk * 16);
      const h8 b0 = *(const h8*)(Bc + kk * 16), b1 = *(const h8*)(Bc + 32 * 40 + kk * 16);
      const h8 b2 = *(const h8*)(Bc + 64 * 40 + kk * 16), b3 = *(const h8*)(Bc + 96 * 40 + kk * 16);
      acc[0][0] = MFMA(a0, b0, acc[0][0]); acc[0][1] = MFMA(a0, b1, acc[0][1]);
      acc[0][2] = MFMA(a0, b2, acc[0][2]); acc[0][3] = MFMA(a0, b3, acc[0][3]);
      acc[1][0] = MFMA(a1, b0, acc[1][0]); acc[1][1] = MFMA(a1, b1, acc[1][1]);
      acc[1][2] = MFMA(a1, b2, acc[1][2]); acc[1][3] = MFMA(a1, b3, acc[1][3]);
    }
    __syncthreads();
  }
#undef WLOAD
#undef WWRITE
  if (!epi.has_tr(col0)) {
    char* sm = smem + wn * STG_T_OFF;
#pragma unroll
    for (int mi = 0; mi < 2; ++mi) {
      epi.frag(sm, row0 + wm * 64 + mi * 32, col0 + wn * 128, wm * 64 + mi * 32, 0, acc[mi][0], acc[mi][1]);
      epi.frag(sm, row0 + wm * 64 + mi * 32, col0 + wn * 128 + 64, wm * 64 + mi * 32, 64, acc[mi][2], acc[mi][3]);
    }
    __syncthreads();
    epi.copy(smem, row0, col0);
    epi.copy(smem + STG_T_OFF, row0, col0 + 128);
    __syncthreads();
    return;
  }
#pragma unroll
  for (int h = 0; h < 2; ++h) {
    if (wn == h) {
#pragma unroll
      for (int mi = 0; mi < 2; ++mi) {
        epi.frag(smem, row0 + wm * 64 + mi * 32, col0 + h * 128, wm * 64 + mi * 32, 0, acc[mi][0], acc[mi][1]);
        epi.frag(smem, row0 + wm * 64 + mi * 32, col0 + h * 128 + 64, wm * 64 + mi * 32, 64, acc[mi][2], acc[mi][3]);
      }
    }
    __syncthreads();
    epi.copy(smem, row0, col0 + h * 128);
    __syncthreads();
  }
}

DI void store_tr(h16* base, const f16v& cc, float bv, int hh) {
#pragma unroll
  for (int g = 0; g < 4; ++g) {
    h4 v;
#pragma unroll
    for (int e = 0; e < 4; ++e) v[e] = (h16)(cc[4 * g + e] + bv);
    *(h4*)(base + 16 * (g >> 1) + 8 * hh + 4 * (g & 1)) = v;
  }
}

DI int perm16pos(int t) { return (t & ~15) | ((t & 3) | ((t & 4) << 1) | ((t & 8) >> 1)); }
DI void stage_tr(h16* stT, int cl, int rlw, int hh, const f16v& cc, float bv) {
#pragma unroll
  for (int g = 0; g < 4; ++g) {
    h4 v;
#pragma unroll
    for (int e = 0; e < 4; ++e) v[e] = (h16)(cc[4 * g + e] + bv);
    *(h4*)(stT + cl * 136 + rlw + 16 * (g >> 1) + 8 * hh + 4 * (g & 1)) = v;
  }
}
template <class F>
DI void copy_tr(const h16* stT, int tid, F dstf) {
#pragma unroll 1
  for (int c = tid; c < 2048; c += 256) {
    const int cl = c >> 4, g8 = c & 15;
    h16* d = dstf(cl);
    if (d) *(uint4*)(d + g8 * 8) = *(const uint4*)(stT + cl * 136 + g8 * 8);
  }
}

struct EpiEven {
  const float* bias; const float* rda; const float* rml;
  h16 *QK4, *VT, *CQKV, *KR, *G;
  DI bool has_tr(int col0) const { return col0 + 256 > 1024 && col0 < 1536; }
  DI void frag(char* smem, int row0, int col0, int rlw, int clw, const f16v& c0, const f16v& c1) const {
    int tid_ = threadIdx.x; asm volatile("" : "+v"(tid_));
    const int lane = tid_ & 63, r = lane & 31, hh = lane >> 5;
    h16* stN = (h16*)smem;
    h16* stT = (h16*)(smem + STG_T_OFF);
    const int b = row0 / TB, jb = row0 - b * TB;
    const bool lat = jb < SEQ;
    if (col0 < 1024) {
      const int ca = col0 + r, cb2 = ca + 32;
      const float ba = bias[ca], bb = bias[cb2];
      const float qs = col0 < 512 ? 0.125f * LOG2E : 1.0f;
#pragma unroll
      for (int i = 0; i < 16; ++i) {
        const int rr = crow(i, hh);
        float v1 = c0[i] + ba, v2 = c1[i] + bb, o1 = v1, o2 = v2;
        if (lat) {
          const float2 cs = *(const float2*)(rda + ((size_t)(jb + rr) * 32 + r) * 2);
          o1 = v1 * cs.x - v2 * cs.y;
          o2 = v2 * cs.x + v1 * cs.y;
        }
        stN[(rlw + rr) * 136 + clw + r] = (h16)(o1 * qs);
        stN[(rlw + rr) * 136 + clw + 32 + r] = (h16)(o2 * qs);
        if ((i & 3) == 3) __builtin_amdgcn_sched_barrier(0);
      }
      return;
    }
#pragma unroll
    for (int half = 0; half < 2; ++half) {
      const int cb = col0 + 32 * half;
      if (cb >= EV_IN) continue;
      const f16v& cc = half ? c1 : c0;
      const int col = cb + r, cl = clw + 32 * half + r;
      const float bv = bias[col];
      if (cb < 1536) {
        stage_tr(stT, cl, rlw, hh, cc, bv);
      } else if (cb < 1920) {
#pragma unroll
        for (int i = 0; i < 16; ++i) stN[(rlw + crow(i, hh)) * 136 + cl] = (h16)(cc[i] + bv);
      } else if (cb == 1920) {
#pragma unroll
        for (int i = 0; i < 16; ++i) {
          const int rr = crow(i, hh);
          float v = cc[i] + bv;
          float pv = __shfl_xor(v, 16);
          float o = v;
          if (lat) {
            const float2 cs = *(const float2*)(rml + ((size_t)(jb + rr) * 16 + (r & 15)) * 2);
            o = (r < 16) ? (v * cs.x - pv * cs.y) : (v * cs.x + pv * cs.y);
          }
          stN[(rlw + rr) * 136 + cl] = (h16)o;
          __builtin_amdgcn_sched_barrier(0);
        }
      } else {
#pragma unroll
        for (int i = 0; i < 16; ++i) stN[(rlw + crow(i, hh)) * 136 + cl] = (h16)silu_f(cc[i] + bv);
      }
    }
  }
  DI void copy(char* smem, int row0, int col0) const {
    int tid = threadIdx.x; asm volatile("" : "+v"(tid));
    const h16* stN = (const h16*)smem;
    const h16* stT = (const h16*)(smem + STG_T_OFF);
    const int b = row0 / TB, jb = row0 - b * TB;
    if (col0 >= 1024 && col0 < 1536) {
      h16* base = VT + ((size_t)b * 512 + (col0 - 1024)) * TB + jb;
      copy_tr(stT, tid, [&](int cl) { return base + (size_t)cl * TB; });
      return;
    }
#pragma unroll 1
    for (int c = tid; c < 2048; c += 256) {
      const int rl = c >> 4, c8 = (c & 15) * 8, col = col0 + c8;
      const size_t row = (size_t)row0 + rl;
      h16* d;
      if (col < 1024) d = QK4 + row * 1024 + col;
      else if (col < 1920) d = CQKV + row * 384 + (col - 1536);
      else if (col < 1952) d = KR + row * 32 + (col - 1920);
      else if (col < EV_IN) d = G + row * 1024 + (col - 1952);
      else continue;
      *(uint4*)d = *(const uint4*)(stN + rl * 136 + c8);
    }
  }
};

struct EpiUQ {
  const float* rstd; int tile_row0; const float* rml; h16* QM;
  DI void frag(char* smem, int row0, int col0, int rlw, int clw, const f16v& c0, const f16v& c1) const {
    int tid_ = threadIdx.x; asm volatile("" : "+v"(tid_));
    const int lane = tid_ & 63, r = lane & 31, hh = lane >> 5;
    h16* stN = (h16*)smem;
    const int b = row0 / TB, jb = row0 - b * TB;
    const bool lat = jb < SEQ;
#pragma unroll
    for (int half = 0; half < 2; ++half) {
      const int cb = col0 + 32 * half;
      const f16v& cc = half ? c1 : c0;
      const bool rope = (cb % 96) == 64;
#pragma unroll
      for (int i = 0; i < 16; ++i) {
        const int rr = crow(i, hh);
        float v = cc[i] * rstd[rlw + rr];
        float pv = __shfl_xor(v, 16);
        float o = v;
        if (rope && lat) {
          const float2 cs = *(const float2*)(rml + ((size_t)(jb + rr) * 16 + (r & 15)) * 2);
          o = (r < 16) ? (v * cs.x - pv * cs.y) : (v * cs.x + pv * cs.y);
        }
        stN[(rlw + rr) * 136 + clw + 32 * half + r] = (h16)(o * (0.10206207261596575f * LOG2E));
        if ((i & 3) == 3) __builtin_amdgcn_sched_barrier(0);
      }
    }
  }
  DI void copy(char* smem, int row0, int col0) const {
    int tid = threadIdx.x; asm volatile("" : "+v"(tid));
    const h16* stN = (const h16*)smem;
#pragma unroll 1
    for (int c = tid; c < 2048; c += 256) {
      const int rl = c >> 4, c8 = (c & 15) * 8;
      *(uint4*)(QM + ((size_t)row0 + rl) * 768 + col0 + c8) = *(const uint4*)(stN + rl * 136 + c8);
    }
  }
};

struct EpiUKV {
  const float* rstd; int tile_row0; h16 *KN, *VMT;
  DI void frag(char* smem, int row0, int col0, int rlw, int clw, const f16v& c0, const f16v& c1) const {
    int tid_ = threadIdx.x; asm volatile("" : "+v"(tid_));
    const int lane = tid_ & 63, r = lane & 31, hh = lane >> 5;
    h16* stN = (h16*)smem;
    h16* stT = (h16*)(smem + STG_T_OFF);
    const bool isv = (col0 & 64) != 0;
#pragma unroll
    for (int half = 0; half < 2; ++half) {
      const f16v& cc = half ? c1 : c0;
      const int cl = clw + 32 * half + r;
      if (!isv) {
#pragma unroll
        for (int i = 0; i < 16; ++i) {
          const int rr = crow(i, hh);
          stN[(rlw + rr) * 136 + cl] = (h16)(cc[i] * rstd[rlw + rr]);
        }
      } else {
#pragma unroll
        for (int g = 0; g < 4; ++g) {
          h4 v;
#pragma unroll
          for (int e = 0; e < 4; ++e) v[e] = (h16)(cc[4 * g + e] * rstd[rlw + 8 * g + 4 * hh + e]);
          *(h4*)(stT + cl * 136 + rlw + 16 * (g >> 1) + 8 * hh + 4 * (g & 1)) = v;
        }
      }
    }
  }
  DI void copy(char* smem, int row0, int col0) const {
    int tid = threadIdx.x; asm volatile("" : "+v"(tid));
    const h16* stN = (const h16*)smem;
    const h16* stT = (const h16*)(smem + STG_T_OFF);
    const int b = row0 / TB, jb = row0 - b * TB;
    const int head = col0 >> 7;
#pragma unroll 1
    for (int c = tid; c < 1024; c += 256) {
      const int rl = c >> 3, c8 = (c & 7) * 8;
      *(uint4*)(KN + ((size_t)row0 + rl) * 512 + head * 64 + c8) = *(const uint4*)(stN + rl * 136 + c8);
    }
    h16* base = VMT + ((size_t)b * 512 + head * 64) * TB + jb;
    copy_tr(stT, tid, [&](int cl) -> h16* { return cl >= 64 ? base + (size_t)(cl - 64) * TB : (h16*)nullptr; });
  }
};

struct EpiOut {
  const float* xin; const float* cin; int layer; const float* mod; const h16* X16; h16* T;
  DI void frag(char* smem, int row0, int col0, int rlw, int clw, const f16v& c0, const f16v& c1) const {
    int tid_ = threadIdx.x; asm volatile("" : "+v"(tid_));
    const int lane = tid_ & 63, r = lane & 31, hh = lane >> 5;
    float* st = (float*)smem;
#pragma unroll
    for (int i = 0; i < 16; ++i) {
      st[(rlw + crow(i, hh)) * 132 + clw + r] = c0[i];
      st[(rlw + crow(i, hh)) * 132 + clw + 32 + r] = c1[i];
    }
  }
  DI void copy(char* smem, int row0, int col0) const {
    int tid = threadIdx.x; asm volatile("" : "+v"(tid));
    const float* st = (const float*)smem;
    const int b = row0 / TB, jb = row0 - b * TB;
    const int mr = jb < SEQ ? b : 4;
    const float* gp = mod + ((size_t)layer * 5 + mr) * 3072 + 2048;
#pragma unroll 1
    for (int c = tid; c < 4096; c += 256) {
      const int rl = c >> 5, c4 = (c & 31) * 4, col = col0 + c4;
      const size_t R = (size_t)row0 + rl;
      const float4 a = *(const float4*)(st + rl * 132 + c4);
      const float4 g = *(const float4*)(gp + col);
      float4 xv;
      if (layer == 0) {
        const int jj = jb + rl;
        const float* xp = jj < SEQ ? xin + ((size_t)b * SEQ + jj) * DM + col : cin + ((size_t)b * CTXL + (jj - SEQ)) * DM + col;
        xv = *(const float4*)xp;
      } else {
        const h4 xh = *(const h4*)(X16 + R * 1024 + col);
        xv.x = (float)xh[0]; xv.y = (float)xh[1]; xv.z = (float)xh[2]; xv.w = (float)xh[3];
      }
      float4 o;
      o.x = DN_ALPHA * xv.x + g.x * a.x; o.y = DN_ALPHA * xv.y + g.y * a.y;
      o.z = DN_ALPHA * xv.z + g.z * a.z; o.w = DN_ALPHA * xv.w + g.w * a.w;
      h4 oh; oh[0] = (h16)o.x; oh[1] = (h16)o.y; oh[2] = (h16)o.z; oh[3] = (h16)o.w;
      *(h4*)(T + R * 1024 + col) = oh;
    }
  }
};

struct EpiOdd {
  const float* bias; h16 *QKP, *MVT, *OG, *NAQ, *NAK, *NAVT, *G; float* GT;
  DI bool has_tr(int col0) const { return (col0 + 256 > 1024 && col0 < 1536) || (col0 + 256 > 3088 && col0 < 3600); }
  DI void frag(char* smem, int row0, int col0, int rlw, int clw, const f16v& c0, const f16v& c1) const {
    int tid_ = threadIdx.x; asm volatile("" : "+v"(tid_));
    const int lane = tid_ & 63, r = lane & 31, hh = lane >> 5;
    h16* stN = (h16*)smem;
    h16* stT = (h16*)(smem + STG_T_OFF);
#pragma unroll
    for (int half = 0; half < 2; ++half) {
      const f16v& cc = half ? c1 : c0;
      const int col = col0 + 32 * half + r, cl = clw + 32 * half + r;
      if (col >= OD_IN) continue;
      const float bv = bias[col];
      const bool tr = (col >= 1024 && col < 1536) || (col >= 3088 && col < 3600);
      if (tr) {
        stage_tr(stT, cl, rlw, hh, cc, bv);
      } else if (col >= 2048 && col < 2064) {
#pragma unroll
        for (int i = 0; i < 16; ++i) GT[(size_t)(row0 + crow(i, hh)) * 16 + (col - 2048)] = cc[i] + bv;
      } else if (col >= 1536 && col < 2048) {
#pragma unroll
        for (int i = 0; i < 16; ++i) stN[(rlw + crow(i, hh)) * 136 + cl] = (h16)sigmoid_f(cc[i] + bv);
      } else if (col >= 3600) {
#pragma unroll
        for (int i = 0; i < 16; ++i) stN[(rlw + crow(i, hh)) * 136 + cl] = (h16)silu_f(cc[i] + bv);
      } else {
#pragma unroll
        for (int i = 0; i < 16; ++i) stN[(rlw + crow(i, hh)) * 136 + cl] = (h16)(cc[i] + bv);
      }
    }
  }
  DI void copy(char* smem, int row0, int col0) const {
    int tid = threadIdx.x; asm volatile("" : "+v"(tid));
    const h16* stN = (const h16*)smem;
    const h16* stT = (const h16*)(smem + STG_T_OFF);
    const int b = row0 / TB, jb = row0 - b * TB;
#pragma unroll 1
    for (int c = tid; c < 2048; c += 256) {
      const int rl = c >> 4, c8 = (c & 15) * 8, col = col0 + c8;
      const size_t row = (size_t)row0 + rl;
      h16* d;
      if (col < 1024) d = QKP + row * 1024 + col;
      else if (col < 1536) continue;
      else if (col < 2048) d = OG + row * 512 + (col - 1536);
      else if (col < 2064) continue;
      else if (col < 2576) d = NAQ + row * 512 + (col - 2064);
      else if (col < 3088) d = NAK + row * 512 + (col - 2576);
      else if (col < 3600) continue;
      else if (col < OD_IN) d = G + row * 1024 + (col - 3600);
      else continue;
      *(uint4*)d = *(const uint4*)(stN + rl * 136 + c8);
    }
    if ((col0 + 128 > 1024 && col0 < 1536) || (col0 + 128 > 3088 && col0 < 3600)) {
      copy_tr(stT, tid, [&](int cl) -> h16* {
        const int col = col0 + cl;
        if (col >= 1024 && col < 1536) return MVT + ((size_t)b * 512 + (col - 1024)) * TB + jb;
        if (col >= 3088 && col < 3600) return NAVT + ((size_t)b * 512 + (col - 3088)) * TB + jb;
        return (h16*)nullptr;
      });
    }
  }
};

DI float softmax_tile(f16v& s, float& m, float& l, float sc, h8& p0, h8& p1) {
  float mx = s[0];
#pragma unroll
  for (int i = 1; i < 16; ++i) mx = fmaxf(mx, s[i]);
  mx = xhalf_max(mx) * sc;
  float mn = m, alpha = 1.0f;
  if (__any(mx > m + 8.0f)) {
    mn = fmaxf(m, mx);
    alpha = __builtin_amdgcn_exp2f(m - mn);
  }
  float sum = 0.f;
#pragma unroll
  for (int i = 0; i < 16; ++i) {
    float pv = __builtin_amdgcn_exp2f(s[i] * sc - mn);
    sum += pv;
    s[i] = pv;
  }
#pragma unroll
  for (int j = 0; j < 8; ++j) { p0[j] = (h16)s[j]; p1[j] = (h16)s[8 + j]; }
  l = l * alpha + sum;
  m = mn;
  return alpha;
}

DI float softmax_shifted(f16v& s, float& m, float& l, h8& qx, bool first, bool lo_half, h8& p0, h8& p1) {
  float sum = 0.f;
#pragma unroll
  for (int i = 0; i < 16; ++i) {
    const float pv = __builtin_amdgcn_exp2f(s[i]);
    sum += pv;
    s[i] = pv;
  }
  float alpha = 1.0f;
  if (__any(sum > 4096.0f) || first) {
    float mx = s[0];
#pragma unroll
    for (int i = 1; i < 16; ++i) mx = fmaxf(mx, s[i]);
    mx = fmaxf(xhalf_max(mx), 1e-30f);
    float d = __builtin_amdgcn_logf(mx);
    if (!first) d = fmaxf(d, 0.f);
    const float mn = (float)(h16)(m + d);
    d = mn - m;
    const float f = __builtin_amdgcn_exp2f(-d);
#pragma unroll
    for (int i = 0; i < 16; ++i) s[i] *= f;
    sum *= f;
    alpha = first ? 1.0f : f;
    m = mn;
    qx[0] = lo_half ? (h16)(-mn) : (h16)0.f;
  }
#pragma unroll
  for (int j = 0; j < 8; ++j) { p0[j] = (h16)s[j]; p1[j] = (h16)s[8 + j]; }
  l = l * alpha + sum;
  return alpha;
}

template <int NMAP, int NKK, int NDVT, class KL, class VL>
DI void flash_wave(const h8 (&qf)[NMAP][NKK], f16v (&O)[NMAP][NDVT], float (&mm)[NMAP], float (&ll)[NMAP], int t0, int t1,
                   float sc, KL kl, VL vl) {
  for (int t = t0; t < t1; ++t) {
    f16v S[NMAP];
    h8 pf[NMAP][2];
    float al[NMAP];
#pragma unroll
    for (int m = 0; m < NMAP; ++m) {
      S[m] = zero16();
#pragma unroll
      for (int kk = 0; kk < NKK; ++kk) S[m] = MFMA(kl(m, kk, t), qf[m][kk], S[m]);
    }
#pragma unroll
    for (int m = 0; m < NMAP; ++m) al[m] = softmax_tile(S[m], mm[m], ll[m], sc, pf[m][0], pf[m][1]);
#pragma unroll
    for (int m = 0; m < NMAP; ++m)
#pragma unroll
      for (int d = 0; d < NDVT; ++d)
#pragma unroll
        for (int i = 0; i < 16; ++i) O[m][d][i] *= al[m];
#pragma unroll
    for (int d = 0; d < NDVT; ++d)
#pragma unroll
      for (int s = 0; s < 2; ++s) {
        h8 vf = vl(d, t, s);
#pragma unroll
        for (int m = 0; m < NMAP; ++m) O[m][d] = MFMA(vf, pf[m][s], O[m][d]);
      }
  }
}

template <int OFF> DI void lds_rd(h8& d, unsigned a) { asm volatile("ds_read_b128 %0, %1 offset:%2" : "=v"(d) : "v"(a), "n"(OFF)); }
#define LGKM_WAIT4(N, a, b, c, d) asm volatile("s_waitcnt lgkmcnt(" #N ")" : "+v"(a), "+v"(b), "+v"(c), "+v"(d))
#define LGKM_WAIT6(N, a, b, c, d, e, f) asm volatile("s_waitcnt lgkmcnt(" #N ")" : "+v"(a), "+v"(b), "+v"(c), "+v"(d), "+v"(e), "+v"(f))
#define LGKM_WAIT8(N, a, b, c, d, e, f, g, h) asm volatile("s_waitcnt lgkmcnt(" #N ")" : "+v"(a), "+v"(b), "+v"(c), "+v"(d), "+v"(e), "+v"(f), "+v"(g), "+v"(h))
#define LGKM_WAIT5(N, a, b, c, d, e) asm volatile("s_waitcnt lgkmcnt(" #N ")" : "+v"(a), "+v"(b), "+v"(c), "+v"(d), "+v"(e))
#define LGKM_WAIT9(N, a, b, c, d, e, f, g, h, i) asm volatile("s_waitcnt lgkmcnt(" #N ")" : "+v"(a), "+v"(b), "+v"(c), "+v"(d), "+v"(e), "+v"(f), "+v"(g), "+v"(h), "+v"(i))

template <int mp>
DI void da_map(const Params& p, int layer, int b, int hd, int qj0, int t0, int t1, float lam, float lam_init, char* smem, int dry) {
  char* ws = p.ws; asm volatile("" : "+s"(ws));
  const h16* QK4 = (const h16*)(ws + OFF_QK4);
  const h16* VT = (const h16*)(ws + OFF_VT);
  h16* AM = (h16*)(ws + OFF_H);
  h16* GY = (h16*)(ws + OFF_GY);
  int tid = threadIdx.x; asm volatile("" : "+v"(tid));
  const int lane = tid & 63, w = tid >> 6, r = lane & 31, hh = lane >> 5;
  const size_t R = (size_t)b * TB + qj0 + w * 32 + r;
  h16* Ks = (h16*)smem;
  h16* Vs = (h16*)(smem + 2 * 9216);
  {
  h8 qf[4];
#pragma unroll
  for (int kk = 0; kk < 4; ++kk) qf[kk] = *(const h8*)(QK4 + R * 1024 + mp * 256 + hd * 64 + kk * 16 + hh * 8);
  const float sc = 0.125f * LOG2E;
  const h16* kg = QK4 + ((size_t)b * TB + (tid >> 3)) * 1024 + 512 + mp * 256 + hd * 64 + (tid & 7) * 8;
  const int kd = (tid >> 3) * 72 + (tid & 7) * 8;
  const h16* vg = VT + ((size_t)b * 512 + hd * 128 + (tid >> 3)) * TB + (tid & 7) * 8;
  const int vd = (tid >> 3) * 72 + (tid & 7) * 8;
  uint4 k0, k1, v0, v1, v2, v3;
#define KLOAD(T) { const h16* s_ = kg + (size_t)(T) * 65536; k0 = *(const uint4*)s_; k1 = *(const uint4*)(s_ + 32768); }
#define KWRITE(ST) { h16* d_ = Ks + (ST) * 4608 + kd; *(uint4*)d_ = k0; *(uint4*)(d_ + 32 * 72) = k1; }
#define VLOAD(T) { const h16* s_ = vg + (T) * 64; v0 = *(const uint4*)s_; v1 = *(const uint4*)(s_ + (size_t)32 * TB); v2 = *(const uint4*)(s_ + (size_t)64 * TB); v3 = *(const uint4*)(s_ + (size_t)96 * TB); }
#define VWRITE(ST) { h16* d_ = Vs + (ST) * 9216 + vd; *(uint4*)d_ = v0; *(uint4*)(d_ + 32 * 72) = v1; *(uint4*)(d_ + 64 * 72) = v2; *(uint4*)(d_ + 96 * 72) = v3; }
  f16v O0 = zero16(), O1 = zero16(), O2 = zero16(), O3 = zero16();
  float m = 0.f, l = 0.f;
  h8 kx, qx;
#pragma unroll
  for (int j = 0; j < 8; ++j) { kx[j] = (h16)0.f; qx[j] = (h16)0.f; }
  kx[0] = hh == 0 ? (h16)1.f : (h16)0.f;
  KLOAD(t0) VLOAD(t0) KWRITE(0) VWRITE(0)
  __syncthreads();
#pragma unroll 1
  for (int t = t0; t < t1; ++t) {
    const int st = (t - t0) & 1;
    const bool more = t + 1 < t1;
    if (more) { KLOAD(t + 1) VLOAD(t + 1) }
    const unsigned ka = (unsigned)(size_t)(Ks + st * 4608 + r * 72 + hh * 8);
    const unsigned va = (unsigned)(size_t)(Vs + st * 9216 + r * 72 + hh * 8);
    h8 a0, a1, a2, a3, b0, b1, b2, b3, g0, g1, g2, g3, g4, g5, g6, g7;
    lds_rd<0>(a0, ka); lds_rd<32>(a1, ka); lds_rd<64>(a2, ka); lds_rd<96>(a3, ka);
    lds_rd<4608 + 0>(b0, ka); lds_rd<4608 + 32>(b1, ka); lds_rd<4608 + 64>(b2, ka); lds_rd<4608 + 96>(b3, ka);
    lds_rd<0>(g0, va); lds_rd<32>(g1, va); lds_rd<4608>(g2, va); lds_rd<4608 + 32>(g3, va);
    lds_rd<9216>(g4, va); lds_rd<9216 + 32>(g5, va); lds_rd<13824>(g6, va); lds_rd<13824 + 32>(g7, va);
    f16v Sa = MFMA(kx, qx, zero16()), Sb = MFMA(kx, qx, zero16());
    LGKM_WAIT4(12, a0, a1, a2, a3);
    Sa = MFMA(a0, qf[0], Sa); Sa = MFMA(a1, qf[1], Sa); Sa = MFMA(a2, qf[2], Sa); Sa = MFMA(a3, qf[3], Sa);
    LGKM_WAIT4(8, b0, b1, b2, b3);
    Sb = MFMA(b0, qf[0], Sb); Sb = MFMA(b1, qf[1], Sb); Sb = MFMA(b2, qf[2], Sb); Sb = MFMA(b3, qf[3], Sb);
    const float mprev = m;
    {
      h8 p0, p1;
      const float al = softmax_shifted(Sa, m, l, qx, t == t0, hh == 0, p0, p1);
      if (__any(al != 1.0f)) {
#pragma unroll
        for (int i = 0; i < 16; ++i) { O0[i] *= al; O1[i] *= al; O2[i] *= al; O3[i] *= al; }
      }
      LGKM_WAIT9(0, g0, g1, g2, g3, g4, g5, g6, g7, p0);
      O0 = MFMA(g0, p0, O0); O1 = MFMA(g2, p0, O1); O2 = MFMA(g4, p0, O2); O3 = MFMA(g6, p0, O3);
      O0 = MFMA(g1, p1, O0); O1 = MFMA(g3, p1, O1); O2 = MFMA(g5, p1, O2); O3 = MFMA(g7, p1, O3);
    }
    lds_rd<64>(g0, va); lds_rd<96>(g1, va); lds_rd<4608 + 64>(g2, va); lds_rd<4608 + 96>(g3, va);
    lds_rd<9216 + 64>(g4, va); lds_rd<9216 + 96>(g5, va); lds_rd<13824 + 64>(g6, va); lds_rd<13824 + 96>(g7, va);
    {
      h8 p0, p1;
      if (m != mprev) {
        const float d = m - mprev;
#pragma unroll
        for (int i = 0; i < 16; ++i) Sb[i] -= d;
      }
      const float al = softmax_shifted(Sb, m, l, qx, false, hh == 0, p0, p1);
      if (__any(al != 1.0f)) {
#pragma unroll
        for (int i = 0; i < 16; ++i) { O0[i] *= al; O1[i] *= al; O2[i] *= al; O3[i] *= al; }
      }
      LGKM_WAIT9(0, g0, g1, g2, g3, g4, g5, g6, g7, p0);
      O0 = MFMA(g0, p0, O0); O1 = MFMA(g2, p0, O1); O2 = MFMA(g4, p0, O2); O3 = MFMA(g6, p0, O3);
      O0 = MFMA(g1, p1, O0); O1 = MFMA(g3, p1, O1); O2 = MFMA(g5, p1, O2); O3 = MFMA(g7, p1, O3);
    }
    if (more) { KWRITE(st ^ 1) VWRITE(st ^ 1) }
    __syncthreads();
  }
#undef KLOAD
#undef KWRITE
#undef VLOAD
#undef VWRITE
  size_t Rm = R; asm volatile("" : "+v"(Rm));
  int hdm = hd; asm volatile("" : "+s"(hdm));
  const float il = 1.f / xhalf_sum(l);
  if (mp == 0) {
#pragma unroll
    for (int d = 0; d < 4; ++d)
#pragma unroll
      for (int g = 0; g < 4; ++g) {
        const int dv = d * 32 + 8 * g + 4 * hh;
        h4 ov;
#pragma unroll
        for (int e = 0; e < 4; ++e) {
          const float o = d == 0 ? O0[4 * g + e] : d == 1 ? O1[4 * g + e] : d == 2 ? O2[4 * g + e] : O3[4 * g + e];
          ov[e] = (h16)(o * il);
        }
        *(h4*)(AM + Rm * 512 + hdm * 128 + dv) = ov;
      }
  } else {
    const float f = lam * il;
    float ss = 0.f;
#pragma unroll
    for (int d = 0; d < 4; ++d)
#pragma unroll
      for (int g = 0; g < 4; ++g) {
        const int dv = d * 32 + 8 * g + 4 * hh;
        const h4 a1 = *(const h4*)(AM + Rm * 512 + hdm * 128 + dv);
#pragma unroll
        for (int e = 0; e < 4; ++e) {
          const float oo = d == 0 ? O0[4 * g + e] : d == 1 ? O1[4 * g + e] : d == 2 ? O2[4 * g + e] : O3[4 * g + e];
          const float o = (float)a1[e] - f * oo;
          if (d == 0) O0[4 * g + e] = o; else if (d == 1) O1[4 * g + e] = o; else if (d == 2) O2[4 * g + e] = o; else O3[4 * g + e] = o;
          ss += o * o;
        }
      }
    ss += __shfl_xor(ss, 32);
    const float rs = rsqrtf(ss * (1.f / 128.f) + 1e-6f) * (1.f - lam_init);
    const float* sg = p.da_subln_g + (layer >> 1) * 128;
    if (!dry) {
#pragma unroll
      for (int d = 0; d < 4; ++d)
#pragma unroll
        for (int g = 0; g < 4; ++g) {
          const int dv = d * 32 + 8 * g + 4 * hh;
          h16* yp = GY + Rm * 1024 + hdm * 128 + dv;
          h4 gv = *(const h4*)yp, ov;
#pragma unroll
          for (int e = 0; e < 4; ++e) {
            const float o = d == 0 ? O0[4 * g + e] : d == 1 ? O1[4 * g + e] : d == 2 ? O2[4 * g + e] : O3[4 * g + e];
            ov[e] = (h16)(o * rs * sg[dv + e] * (float)gv[e]);
          }
          *(h4*)yp = ov;
        }
    }
  }
  }
}

DI void da_item(const Params& p, int layer, int b, int hd, int qj0, int t0, int t1, float lam, float lam_init, char* smem, int dry) {
  da_map<0>(p, layer, b, hd, qj0, t0, t1, lam, lam_init, smem, dry);
  da_map<1>(p, layer, b, hd, qj0, t0, t1, lam, lam_init, smem, dry);
}

DI void mla_item(const Params& p, int b, int hd, int qj0, int t0, int t1, char* smem, int dry) {
  char* ws = p.ws; asm volatile("" : "+s"(ws));
  const h16* QM = (const h16*)(ws + OFF_QM);
  const h16* KN = (const h16*)(ws + OFF_KN);
  const h16* KR = (const h16*)(ws + OFF_KR);
  const h16* VMT = (const h16*)(ws + OFF_VMT);
  h16* GY = (h16*)(ws + OFF_GY);
  int tid = threadIdx.x; asm volatile("" : "+v"(tid));
  const int lane = tid & 63, w = tid >> 6, r = lane & 31, hh = lane >> 5;
  const size_t R = (size_t)b * TB + qj0 + w * 64 + r;
  h16* Ks = (h16*)smem;
  h16* Vs = (h16*)(smem + 2 * 13312);
  h8 qa[6], qb[6];
#pragma unroll
  for (int kk = 0; kk < 6; ++kk) {
    qa[kk] = *(const h8*)(QM + R * 768 + hd * 96 + kk * 16 + hh * 8);
    qb[kk] = *(const h8*)(QM + (R + 32) * 768 + hd * 96 + kk * 16 + hh * 8);
  }
  const float sc = 0.10206207261596575f * LOG2E;
  const h16* kng = KN + ((size_t)b * TB + (tid >> 3)) * 512 + hd * 64 + (tid & 7) * 8;
  const int knd = (tid >> 3) * 104 + (tid & 7) * 8;
  const h16* krg = KR + ((size_t)b * TB + (tid >> 2)) * 32 + (tid & 3) * 8;
  const int krd = (tid >> 2) * 104 + 64 + (tid & 3) * 8;
  const h16* vg = VMT + ((size_t)b * 512 + hd * 64 + (tid >> 3)) * TB + (tid & 7) * 8;
  const int vd = (tid >> 3) * 72 + (tid & 7) * 8;
  uint4 k0, k1, k2, v0, v1;
#define MLOAD(T) { const h16* s_ = kng + (size_t)(T) * 32768; k0 = *(const uint4*)s_; k1 = *(const uint4*)(s_ + 16384); k2 = *(const uint4*)(krg + (size_t)(T) * 2048); \
                   const h16* u_ = vg + (T) * 64; v0 = *(const uint4*)u_; v1 = *(const uint4*)(u_ + (size_t)32 * TB); }
#define MWRITE(ST) { h16* d_ = Ks + (ST) * 6656; *(uint4*)(d_ + knd) = k0; *(uint4*)(d_ + knd + 32 * 104) = k1; *(uint4*)(d_ + krd) = k2; \
                     h16* e_ = Vs + (ST) * 4608 + vd; *(uint4*)e_ = v0; *(uint4*)(e_ + 32 * 72) = v1; }
  f16v Oa0 = zero16(), Oa1 = zero16(), Ob0 = zero16(), Ob1 = zero16();
  float ma = 0.f, la = 0.f, mb = 0.f, lb = 0.f;
  h8 kx, qxa, qxb;
#pragma unroll
  for (int j = 0; j < 8; ++j) { kx[j] = (h16)0.f; qxa[j] = (h16)0.f; qxb[j] = (h16)0.f; }
  kx[0] = hh == 0 ? (h16)1.f : (h16)0.f;
  MLOAD(t0) MWRITE(0)
  __syncthreads();
#pragma unroll 1
  for (int t = t0; t < t1; ++t) {
    const int st = (t - t0) & 1;
    const bool more = t + 1 < t1;
    const unsigned ka = (unsigned)(size_t)(Ks + st * 6656 + r * 104 + hh * 8);
    const unsigned va = (unsigned)(size_t)(Vs + st * 4608 + r * 72 + hh * 8);
#pragma unroll 2
    for (int sub = 0; sub < 2; ++sub) {
      if (sub == 1 && more) MLOAD(t + 1)
      const unsigned kas = ka + sub * 6656, vas = va + sub * 64;
      h8 f0, f1, f2, f3, f4, f5, g0, g1, g2, g3;
      lds_rd<0>(f0, kas); lds_rd<32>(f1, kas); lds_rd<64>(f2, kas); lds_rd<96>(f3, kas); lds_rd<128>(f4, kas); lds_rd<160>(f5, kas);
      f16v Sa = MFMA(kx, qxa, zero16()), Sb = MFMA(kx, qxb, zero16());
      LGKM_WAIT6(0, f0, f1, f2, f3, f4, f5);
      Sa = MFMA(f0, qa[0], Sa); Sb = MFMA(f0, qb[0], Sb);
      Sa = MFMA(f1, qa[1], Sa); Sb = MFMA(f1, qb[1], Sb);
      Sa = MFMA(f2, qa[2], Sa); Sb = MFMA(f2, qb[2], Sb);
      Sa = MFMA(f3, qa[3], Sa); Sb = MFMA(f3, qb[3], Sb);
      Sa = MFMA(f4, qa[4], Sa); Sb = MFMA(f4, qb[4], Sb);
      Sa = MFMA(f5, qa[5], Sa); Sb = MFMA(f5, qb[5], Sb);
      h8 pa0, pa1, pb0, pb1;
      const bool first = (t == t0) && (sub == 0);
      const float ala = softmax_shifted(Sa, ma, la, qxa, first, hh == 0, pa0, pa1);
      if (__any(ala != 1.0f)) {
#pragma unroll
        for (int i = 0; i < 16; ++i) { Oa0[i] *= ala; Oa1[i] *= ala; }
      }
      lds_rd<0>(g0, vas); lds_rd<32>(g1, vas); lds_rd<4608>(g2, vas); lds_rd<4608 + 32>(g3, vas);
      const float alb = softmax_shifted(Sb, mb, lb, qxb, first, hh == 0, pb0, pb1);
      if (__any(alb != 1.0f)) {
#pragma unroll
        for (int i = 0; i < 16; ++i) { Ob0[i] *= alb; Ob1[i] *= alb; }
      }
      LGKM_WAIT6(0, g0, g1, g2, g3, pa0, pb0);
      Oa0 = MFMA(g0, pa0, Oa0); Ob0 = MFMA(g0, pb0, Ob0);
      Oa1 = MFMA(g2, pa0, Oa1); Ob1 = MFMA(g2, pb0, Ob1);
      Oa0 = MFMA(g1, pa1, Oa0); Ob0 = MFMA(g1, pb1, Ob0);
      Oa1 = MFMA(g3, pa1, Oa1); Ob1 = MFMA(g3, pb1, Ob1);
    }
    if (more) MWRITE(st ^ 1)
    __syncthreads();
  }
#undef MLOAD
#undef MWRITE
  const float ia = 1.f / xhalf_sum(la), ib = 1.f / xhalf_sum(lb);
  if (!dry) {
#pragma unroll
    for (int d = 0; d < 2; ++d)
#pragma unroll
      for (int g = 0; g < 4; ++g) {
        const int dv = d * 32 + 8 * g + 4 * hh;
        {
          h16* yp = GY + R * 1024 + 512 + hd * 64 + dv;
          h4 gv = *(const h4*)yp, ov;
#pragma unroll
          for (int e = 0; e < 4; ++e) ov[e] = (h16)((d ? Oa1[4 * g + e] : Oa0[4 * g + e]) * ia * (float)gv[e]);
          *(h4*)yp = ov;
        }
        {
          h16* yp = GY + (R + 32) * 1024 + 512 + hd * 64 + dv;
          h4 gv = *(const h4*)yp, ov;
#pragma unroll
          for (int e = 0; e < 4; ++e) ov[e] = (h16)((d ? Ob1[4 * g + e] : Ob0[4 * g + e]) * ib * (float)gv[e]);
          *(h4*)yp = ov;
        }
      }
  }
}

DI void na_wave(const Params& p, int layer, int b, int gr, int hp, char* smem, int dry) {
  char* ws = p.ws; asm volatile("" : "+s"(ws));
  const h16* NAQ = (const h16*)(ws + OFF_NAQ);
  const h16* NAK = (const h16*)(ws + OFF_NAK);
  const h16* NAVT = (const h16*)(ws + OFF_NAVT);
  h16* GY = (h16*)(ws + OFF_GY);
  int tid_ = threadIdx.x; asm volatile("" : "+v"(tid_));
  const int lane = tid_ & 63, w = tid_ >> 6, r = lane & 31, hh = lane >> 5;
  const int hd = hp * 2 + (w >> 1), half = w & 1;
  float* tbl = (float*)smem;
  __syncthreads();
  for (int i = tid_; i < 2 * 465; i += 256) {
    const int hs = i >= 465, j = i - hs * 465;
    tbl[hs * 480 + j] = p.na_rpb[((size_t)(layer >> 1) * 8 + hp * 2 + hs) * 465 + j];
  }
  __syncthreads();
  const float* rpb = tbl + (w >> 1) * 480;
  const int c = half * 32 + r;
  const int cs = min(max(c - 8, 0), 48);
  const int rs = min(max(gr - 4, 0), 120);
  const size_t R = (size_t)b * TB + gr * 64 + c;
  h8 qf[4];
#pragma unroll
  for (int kk = 0; kk < 4; ++kk) qf[kk] = *(const h8*)(NAQ + R * 512 + hd * 64 + kk * 16 + hh * 8);
  f16v O0 = zero16(), O1 = zero16();
  float m = -1e30f, l = 0.f;
  const float sc = 0.125f * LOG2E;
  const h16* kbase = NAK + ((size_t)b * TB + r) * 512 + hd * 64 + hh * 8;
  const h16* vbase = NAVT + ((size_t)b * 512 + hd * 64 + r) * TB + 8 * hh;
  auto tile_j0 = [&](int t) { return t < 16 ? (rs + (t >> 1)) * 64 + (t & 1) * 32 : SEQ + (t - 16) * 32; };
  struct Fr { h8 k0, k1, k2, k3, v00, v01, v10, v11; };
  auto load = [&](int t) {
    const int j0 = tile_j0(t);
    const h16* kp = kbase + (size_t)j0 * 512;
    const h16* vb = vbase + j0;
    Fr f;
    f.k0 = *(const h8*)(kp); f.k1 = *(const h8*)(kp + 16); f.k2 = *(const h8*)(kp + 32); f.k3 = *(const h8*)(kp + 48);
    f.v00 = *(const h8*)(vb); f.v01 = *(const h8*)(vb + 16);
    f.v10 = *(const h8*)(vb + (size_t)32 * TB); f.v11 = *(const h8*)(vb + (size_t)32 * TB + 16);
    return f;
  };
  auto compute = [&](const Fr& f, int t) {
    f16v S = zero16();
    S = MFMA(f.k0, qf[0], S); S = MFMA(f.k1, qf[1], S); S = MFMA(f.k2, qf[2], S); S = MFMA(f.k3, qf[3], S);
    float mx = -1e30f;
    if (t < 16) {
      const int krow_g = rs + (t >> 1), kc0 = (t & 1) * 32;
      const float* bp = rpb + (krow_g - gr + 7) * 31 + (15 - c);
#pragma unroll
      for (int i = 0; i < 16; ++i) {
        const int kj = kc0 + crow(i, hh);
        const bool valid = (kj >= cs) && (kj < cs + 16);
        float v = -1e30f;
        if (valid) v = (S[i] * 0.125f + bp[kj]) * LOG2E;
        S[i] = v;
        mx = fmaxf(mx, v);
      }
    } else {
#pragma unroll
      for (int i = 0; i < 16; ++i) { S[i] *= sc; mx = fmaxf(mx, S[i]); }
    }
    mx = xhalf_max(mx);
    const float mn = fmaxf(m, mx);
    const float alpha = __builtin_amdgcn_exp2f(m - mn);
    float sum = 0.f;
#pragma unroll
    for (int i = 0; i < 16; ++i) {
      float pv = (S[i] > -1e29f) ? __builtin_amdgcn_exp2f(S[i] - mn) : 0.f;
      sum += pv;
      S[i] = pv;
    }
    l = l * alpha + sum;
    m = mn;
    h8 p0, p1;
#pragma unroll
    for (int j = 0; j < 8; ++j) { p0[j] = (h16)S[j]; p1[j] = (h16)S[8 + j]; }
    if (__any(alpha != 1.0f)) {
#pragma unroll
      for (int i = 0; i < 16; ++i) { O0[i] *= alpha; O1[i] *= alpha; }
    }
    O0 = MFMA(f.v00, p0, O0); O0 = MFMA(f.v01, p1, O0);
    O1 = MFMA(f.v10, p0, O1); O1 = MFMA(f.v11, p1, O1);
  };
  Fr fa = load(0);
#pragma unroll 1
  for (int t = 0; t < 24; t += 2) {
    Fr fb = load(t + 1);
    __builtin_amdgcn_sched_barrier(0);
    compute(fa, t);
    __builtin_amdgcn_sched_barrier(0);
    if (t + 2 < 24) fa = load(t + 2);
    __builtin_amdgcn_sched_barrier(0);
    compute(fb, t + 1);
    __builtin_amdgcn_sched_barrier(0);
  }
  l += __shfl_xor(l, 32);
  const float il = 1.f / l;
  if (!dry)
#pragma unroll
  for (int d = 0; d < 2; ++d)
#pragma unroll
    for (int g = 0; g < 4; ++g) {
      const int dv = d * 32 + 8 * g + 4 * hh;
      h16* yp = GY + R * 1024 + 512 + hd * 64 + dv;
      h4 gv = *(const h4*)yp, ov;
#pragma unroll
      for (int e = 0; e < 4; ++e) ov[e] = (h16)((d ? O1[4 * g + e] : O0[4 * g + e]) * il * (float)gv[e]);
      *(h4*)yp = ov;
    }
}

DI void nactx_item(const Params& p, int b, int hd, int qt, int dry) {
  char* ws = p.ws; asm volatile("" : "+s"(ws));
  const h16* NAQ = (const h16*)(ws + OFF_NAQ);
  const h16* NAK = (const h16*)(ws + OFF_NAK);
  const h16* NAVT = (const h16*)(ws + OFF_NAVT);
  h16* GY = (h16*)(ws + OFF_GY);
  int tid_ = threadIdx.x; asm volatile("" : "+v"(tid_));
  const int lane = tid_ & 63, w = tid_ >> 6, r = lane & 31, hh = lane >> 5;
  const size_t R = (size_t)b * TB + SEQ + qt * 128 + w * 32 + r;
  h8 qf[1][4];
#pragma unroll
  for (int kk = 0; kk < 4; ++kk) qf[0][kk] = *(const h8*)(NAQ + R * 512 + hd * 64 + kk * 16 + hh * 8);
  f16v O[1][2];
  O[0][0] = zero16(); O[0][1] = zero16();
  float mm[1] = {-1e30f}, ll[1] = {0.f};
  const h16* kb = NAK + ((size_t)b * TB + r) * 512 + hd * 64 + hh * 8;
  const h16* vbase = NAVT + ((size_t)b * 512 + hd * 64 + r) * TB + 8 * hh;
  flash_wave<1, 4, 2>(qf, O, mm, ll, 256, 264, 0.125f * LOG2E,
      [&](int m, int kk, int t) { return *(const h8*)(kb + (size_t)t * 32 * 512 + kk * 16); },
      [&](int d, int t, int s) { return *(const h8*)(vbase + (size_t)d * 32 * TB + t * 32 + 16 * s); });
  const float l1 = ll[0] + __shfl_xor(ll[0], 32);
  const float i1 = 1.f / l1;
  if (!dry)
#pragma unroll
  for (int d = 0; d < 2; ++d)
#pragma unroll
    for (int g = 0; g < 4; ++g) {
      const int dv = d * 32 + 8 * g + 4 * hh;
      h16* yp = GY + R * 1024 + 512 + hd * 64 + dv;
      h4 gv = *(const h4*)yp, ov;
#pragma unroll
      for (int e = 0; e < 4; ++e) ov[e] = (h16)(O[0][d][4 * g + e] * i1 * (float)gv[e]);
      *(h4*)yp = ov;
    }
}

DI int chunk_j0(int dir, int k) {
  if (k < 2) return SEQ + (dir ? 1 - k : k) * 128;
  return (dir ? 63 - (k - 2) : (k - 2)) * 128;
}
DI int tokchunk_k(int dir, int kc) {
  if (kc >= 64) { int cc = kc - 64; return dir ? 1 - cc : cc; }
  return 2 + (dir ? 63 - kc : kc);
}

DI void scan_sum2(float v0, float v1, int lane, float& o0, float& o1) {
  float s = v0 + v1;
#pragma unroll
  for (int off = 1; off < 64; off <<= 1) { float t = __shfl_up(s, off); if (lane >= off) s += t; }
  o1 = s; o0 = s - v1;
}
DI void scan_max2(float v0, float v1, int lane, float& o0, float& o1) {
  float s = fmaxf(v0, v1);
#pragma unroll
  for (int off = 1; off < 64; off <<= 1) { float t = __shfl_up(s, off); if (lane >= off) s = fmaxf(s, t); }
  float ex = __shfl_up(s, 1);
  if (lane == 0) ex = -1e30f;
  o1 = s; o0 = fmaxf(ex, v0);
}

DI void conv8(const h16* __restrict__ QKP, size_t rowbase, int pidx, int col, bool has_prev, bool has_next,
              const float* __restrict__ cw, const float* __restrict__ cb, float (&y)[8]) {
  {
    const float4 b0 = *(const float4*)(cb + col), b1 = *(const float4*)(cb + col + 4);
    y[0] = b0.x; y[1] = b0.y; y[2] = b0.z; y[3] = b0.w; y[4] = b1.x; y[5] = b1.y; y[6] = b1.z; y[7] = b1.w;
  }
#pragma unroll
  for (int t = 0; t < 5; ++t) {
    const int pp = pidx + t - 2;
    const bool ok = (pp >= 0 || has_prev) && (pp < 128 || has_next);
    if (ok) {
      const h8 xv = *(const h8*)(QKP + (size_t)((long)rowbase + pp) * 1024 + col);
      const float4 w0 = *(const float4*)(cw + t * 1024 + col), w1 = *(const float4*)(cw + t * 1024 + col + 4);
      y[0] += (float)xv[0] * w0.x; y[1] += (float)xv[1] * w0.y; y[2] += (float)xv[2] * w0.z; y[3] += (float)xv[3] * w0.w;
      y[4] += (float)xv[4] * w1.x; y[5] += (float)xv[5] * w1.y; y[6] += (float)xv[6] * w1.z; y[7] += (float)xv[7] * w1.w;
    }
  }
#pragma unroll
  for (int e = 0; e < 8; ++e) y[e] = silu_f(y[e]);
}

struct ConvW { float4 w[5][2]; float4 b[2]; };
DI ConvW load_convw(const float* __restrict__ cw, const float* __restrict__ cb, int col) {
  ConvW c;
#pragma unroll
  for (int t = 0; t < 5; ++t) { c.w[t][0] = *(const float4*)(cw + t * 1024 + col); c.w[t][1] = *(const float4*)(cw + t * 1024 + col + 4); }
  c.b[0] = *(const float4*)(cb + col); c.b[1] = *(const float4*)(cb + col + 4);
  return c;
}
DI void conv8w(const h16* __restrict__ QKP, size_t rowbase, int pidx, int col, bool has_prev, bool has_next, const ConvW& c, float (&y)[8]) {
  y[0] = c.b[0].x; y[1] = c.b[0].y; y[2] = c.b[0].z; y[3] = c.b[0].w; y[4] = c.b[1].x; y[5] = c.b[1].y; y[6] = c.b[1].z; y[7] = c.b[1].w;
#pragma unroll
  for (int t = 0; t < 5; ++t) {
    const int pp = pidx + t - 2;
    const bool ok = (pp >= 0 || has_prev) && (pp < 128 || has_next);
    if (ok) {
      const h8 xv = *(const h8*)(QKP + (size_t)((long)rowbase + pp) * 1024 + col);
      y[0] += (float)xv[0] * c.w[t][0].x; y[1] += (float)xv[1] * c.w[t][0].y; y[2] += (float)xv[2] * c.w[t][0].z; y[3] += (float)xv[3] * c.w[t][0].w;
      y[4] += (float)xv[4] * c.w[t][1].x; y[5] += (float)xv[5] * c.w[t][1].y; y[6] += (float)xv[6] * c.w[t][1].z; y[7] += (float)xv[7] * c.w[t][1].w;
    }
  }
#pragma unroll
  for (int e = 0; e < 8; ++e) y[e] = silu_f(y[e]);
}

constexpr float K_SCALE = 0.08838834764831845f;

DI void m1_item(const Params& p, int layer, int c, int k, char* smem) {
  char* ws = p.ws; asm volatile("" : "+s"(ws));
  const h16* QKP = (const h16*)(ws + OFF_QKP);
  const h16* MVT = (const h16*)(ws + OFF_MVT);
  const float* GT = (const float*)(ws + OFF_GT);
  h16* UT = (h16*)(ws + OFF_H);
  float* BT = (float*)(ws + OFF_BT);
  float* GM = (float*)(ws + OFF_GM);
  float* NL = (float*)(ws + OFF_NL);
  const int li_ = layer >> 1;
  const int dir = c & 1, hd = (c >> 1) & 3, b = c >> 3;
  const int j0 = chunk_j0(dir, k);
  const size_t R0 = (size_t)b * TB + j0;
  h16* KT = (h16*)smem;
  float* WL = (float*)(smem + 128 * 136 * 2);
  int tid = threadIdx.x; asm volatile("" : "+v"(tid));
  const int lane = tid & 63, w = tid >> 6, r = lane & 31, hh = lane >> 5;
  if (w == 0) {
    const int r0 = 2 * lane, r1 = r0 + 1;
    const int p0 = dir ? 127 - r0 : r0, p1 = dir ? 127 - r1 : r1;
    const float fb = p.ml_f_bias[(li_ * 2 + dir) * 4 + hd];
    const float li0 = GT[(R0 + p0) * 16 + (2 * dir) * 4 + hd], li1 = GT[(R0 + p1) * 16 + (2 * dir) * 4 + hd];
    const float lf0 = logsig_f(GT[(R0 + p0) * 16 + (2 * dir + 1) * 4 + hd] + fb);
    const float lf1 = logsig_f(GT[(R0 + p1) * 16 + (2 * dir + 1) * 4 + hd] + fb);
    float bc0, bc1;
    scan_sum2(lf0, lf1, lane, bc0, bc1);
    const float btot = __shfl(bc1, 63);
    const float g0 = btot - bc0 + li0, g1 = btot - bc1 + li1;
    float gm = fmaxf(g0, g1);
#pragma unroll
    for (int off = 32; off > 0; off >>= 1) gm = fmaxf(gm, __shfl_xor(gm, off));
    WL[p0] = __expf(g0 - gm);
    WL[p1] = __expf(g1 - gm);
    if (lane == 0) { BT[c * NCHUNK + k] = btot; GM[c * NCHUNK + k] = gm; }
  }
  __syncthreads();
  const bool has_prev = (j0 != 0) && (j0 != SEQ);
  const bool has_next = (j0 + 128 != SEQ) && (j0 + 128 != TB);
  const float* cw = p.ml_conv_w + (size_t)li_ * 5 * 1024;
  const float* cb = p.ml_conv_b + (size_t)li_ * 1024;
  const ConvW cvw = load_convw(cw, cb, 512 + hd * 128 + (tid & 15) * 8);
#pragma unroll 4
  for (int it = tid; it < 128 * 16; it += 256) {
    const int pp = it >> 4, ch0 = (it & 15) * 8;
    float y[8];
    conv8w(QKP, R0, pp, 512 + hd * 128 + ch0, has_prev, has_next, cvw, y);
    const float wv = WL[pp] * K_SCALE;
    const int o16 = pp & 15;
    const int ppos = (pp & ~15) | ((o16 & 3) | ((o16 & 4) << 1) | ((o16 & 8) >> 1));
#pragma unroll
    for (int e = 0; e < 8; ++e) KT[(ch0 + e) * 136 + ppos] = (h16)(y[e] * wv);
  }
  __syncthreads();
  if (tid < 128) {
    float s = 0.f;
#pragma unroll 8
    for (int q = 0; q < 128; ++q) s += (float)KT[tid * 136 + q];
    NL[((size_t)c * NCHUNK + k) * 128 + tid] = s;
  }
  f16v acc[4];
#pragma unroll
  for (int d = 0; d < 4; ++d) acc[d] = zero16();
  const h16* vp = MVT + ((size_t)b * 512 + hd * 128 + w * 32 + r) * TB + j0 + hh * 8;
  h8 af[8];
#pragma unroll
  for (int ks = 0; ks < 8; ++ks) af[ks] = *(const h8*)(vp + ks * 16);
  __builtin_amdgcn_sched_barrier(0);
#pragma unroll
  for (int ks = 0; ks < 8; ++ks) {
#pragma unroll
    for (int d = 0; d < 4; ++d) {
      const h8 bb = *(const h8*)(KT + (d * 32 + r) * 136 + ks * 16 + hh * 8);
      acc[d] = MFMA(af[ks], bb, acc[d]);
    }
  }
  h16* up = UT + ((size_t)c * NCHUNK + k) * 16384;
#pragma unroll
  for (int d = 0; d < 4; ++d)
#pragma unroll
    for (int i = 0; i < 16; ++i) up[(w * 32 + crow(i, hh)) * 128 + d * 32 + r] = (h16)acc[d][i];
  __syncthreads();
}

DI void m3_item(const Params& p, int layer, int b, int hd, int kc, char* smem, int dry) {
  char* ws = p.ws; asm volatile("" : "+s"(ws));
  const h16* QKP = (const h16*)(ws + OFF_QKP);
  const h16* MVT = (const h16*)(ws + OFF_MVT);
  const h16* OG = (const h16*)(ws + OFF_OG);
  const float* GT = (const float*)(ws + OFF_GT);
  const h16* UT = (const h16*)(ws + OFF_H);
  const float* MP = (const float*)(ws + OFF_MP);
  const float* NL = (const float*)(ws + OFF_NL);
  h16* GY = (h16*)(ws + OFF_GY);
  const int li_ = layer >> 1;
  const int j0 = kc < 64 ? kc * 128 : SEQ + (kc - 64) * 128;
  const size_t R0 = (size_t)b * TB + j0;
  h16* Qs = (h16*)smem;
  h16* Ks = Qs + 128 * 136;
  float* BC = (float*)(smem + 2 * 128 * 136 * 2);
  float* AA = BC + 128;
  float* MT = AA + 128;
  float* NP = MT + 128;
  int tid = threadIdx.x; asm volatile("" : "+v"(tid));
  const int lane = tid & 63, w = tid >> 6, r = lane & 31, hh = lane >> 5;
  const bool has_prev = (j0 != 0) && (j0 != SEQ);
  const bool has_next = (j0 + 128 != SEQ) && (j0 + 128 != TB);
  const float* cw = p.ml_conv_w + (size_t)li_ * 5 * 1024;
  const float* cb = p.ml_conv_b + (size_t)li_ * 1024;
  const ConvW cvw = load_convw(cw, cb, ((tid & 31) >> 4) * 512 + hd * 128 + (tid & 15) * 8);
#pragma unroll 4
  for (int it = tid; it < 128 * 32; it += 256) {
    const int pp = it >> 5, cg = it & 31, which = cg >> 4, ch0 = (cg & 15) * 8;
    float y[8];
    conv8w(QKP, R0, pp, which * 512 + hd * 128 + ch0, has_prev, has_next, cvw, y);
    h8 o;
    const float sc = which ? K_SCALE : 1.f;
#pragma unroll
    for (int e = 0; e < 8; ++e) o[e] = (h16)(y[e] * sc);
    *(h8*)((which ? Ks : Qs) + pp * 136 + ch0) = o;
  }
  __syncthreads();
  const int tq = w * 32 + r;
  const unsigned qad = (unsigned)(size_t)(Qs + tq * 136 + hh * 8);
#define LOADQ(q) { lds_rd<0>(q[0], qad); lds_rd<32>(q[1], qad); lds_rd<64>(q[2], qad); lds_rd<96>(q[3], qad); \
                   lds_rd<128>(q[4], qad); lds_rd<160>(q[5], qad); lds_rd<192>(q[6], qad); lds_rd<224>(q[7], qad); \
                   LGKM_WAIT8(0, q[0], q[1], q[2], q[3], q[4], q[5], q[6], q[7]); }
  f16v hs[4];
#pragma unroll
  for (int d = 0; d < 4; ++d) hs[d] = zero16();
#pragma unroll 1
  for (int dir = 0; dir < 2; ++dir) {
    const int c = (b * 4 + hd) * 2 + dir;
    const int k = tokchunk_k(dir, kc);
    const float mprev = MP[c * NCHUNK + k];
    if (w == 0) {
      const int r0 = 2 * lane, r1 = r0 + 1;
      const int p0 = dir ? 127 - r0 : r0, p1 = dir ? 127 - r1 : r1;
      const float fb = p.ml_f_bias[(li_ * 2 + dir) * 4 + hd];
      const float li0 = GT[(R0 + p0) * 16 + (2 * dir) * 4 + hd], li1 = GT[(R0 + p1) * 16 + (2 * dir) * 4 + hd];
      const float lf0 = logsig_f(GT[(R0 + p0) * 16 + (2 * dir + 1) * 4 + hd] + fb);
      const float lf1 = logsig_f(GT[(R0 + p1) * 16 + (2 * dir + 1) * 4 + hd] + fb);
      float bc0, bc1, pm0, pm1;
      scan_sum2(lf0, lf1, lane, bc0, bc1);
      const float a0 = li0 - bc0, a1 = li1 - bc1;
      scan_max2(a0, a1, lane, pm0, pm1);
      BC[p0] = bc0; BC[p1] = bc1; AA[p0] = a0; AA[p1] = a1;
      MT[p0] = fmaxf(mprev, pm0); MT[p1] = fmaxf(mprev, pm1);
    } else if (w == 1) {
      NP[lane] = NL[((size_t)c * NCHUNK + k) * 128 + lane];
      NP[lane + 64] = NL[((size_t)c * NCHUNK + k) * 128 + lane + 64];
    }
    __syncthreads();
    const float mt = MT[tq];
    const float wc = __expf(mprev - mt);
    f16v acc[4];
    float qn = 0.f;
    {
    h8 qf[8];
    LOADQ(qf)
    const h16* cp = UT + ((size_t)c * NCHUNK + k) * 16384 + (size_t)r * 128 + hh * 8;
#pragma unroll
    for (int d = 0; d < 4; ++d) {
      acc[d] = zero16();
      h8 cf[8];
#pragma unroll
      for (int kk = 0; kk < 8; ++kk) cf[kk] = *(const h8*)(cp + d * 32 * 128 + kk * 16);
      __builtin_amdgcn_sched_barrier(0);
#pragma unroll
      for (int kk = 0; kk < 8; ++kk) acc[d] = MFMA(cf[kk], qf[kk], acc[d]);
#pragma unroll
      for (int i = 0; i < 16; ++i) acc[d][i] *= wc;
      __builtin_amdgcn_sched_barrier(0);
    }
#pragma unroll
    for (int kk = 0; kk < 8; ++kk)
#pragma unroll
      for (int e = 0; e < 8; ++e) qn += (float)qf[kk][e] * NP[kk * 16 + hh * 8 + e];
    }
    qn += __shfl_xor(qn, 32);
    float den = 0.f;
    const int st0 = dir ? w : 0, st1 = dir ? 4 : w + 1;
#pragma unroll 1
    for (int st = st0; st < st1; ++st) {
      f16v S = zero16();
      {
        h8 qf[8];
        LOADQ(qf)
        h8 kf[8];
#pragma unroll
        for (int kk = 0; kk < 8; ++kk) kf[kk] = *(const h8*)(Ks + (st * 32 + r) * 136 + kk * 16 + hh * 8);
        __builtin_amdgcn_sched_barrier(0);
#pragma unroll
        for (int kk = 0; kk < 8; ++kk) S = MFMA(kf[kk], qf[kk], S);
        __builtin_amdgcn_sched_barrier(0);
      }
      const h16* vb = MVT + ((size_t)b * 512 + hd * 128 + r) * TB + j0 + st * 32 + 8 * hh;
      h8 vf[8];
#pragma unroll
      for (int d = 0; d < 4; ++d) { vf[2 * d] = *(const h8*)(vb + (size_t)d * 32 * TB); vf[2 * d + 1] = *(const h8*)(vb + (size_t)d * 32 * TB + 16); }
      __builtin_amdgcn_sched_barrier(0);
#pragma unroll
      for (int i = 0; i < 16; ++i) {
        const int s = st * 32 + crow(i, hh);
        const bool valid = dir ? (s >= tq) : (s <= tq);
        float wgt = valid ? __expf(AA[s] - mt) * S[i] : 0.f;
        den += wgt;
        S[i] = wgt;
      }
      h8 p0, p1;
#pragma unroll
      for (int j = 0; j < 8; ++j) { p0[j] = (h16)S[j]; p1[j] = (h16)S[8 + j]; }
#pragma unroll
      for (int d = 0; d < 4; ++d) {
        acc[d] = MFMA(vf[2 * d], p0, acc[d]);
        acc[d] = MFMA(vf[2 * d + 1], p1, acc[d]);
      }
    }
    den += __shfl_xor(den, 32);
    den += wc * qn;
    const float dn = fmaxf(fabsf(den), __expf(-(BC[tq] + mt)));
    const float idn = 1.f / dn;
#pragma unroll
    for (int d = 0; d < 4; ++d)
#pragma unroll
      for (int i = 0; i < 16; ++i) hs[d][i] += acc[d][i] * idn;
    __syncthreads();
  }
  float sm = 0.f;
#pragma unroll
  for (int d = 0; d < 4; ++d)
#pragma unroll
    for (int i = 0; i < 16; ++i) sm += hs[d][i];
  sm += __shfl_xor(sm, 32);
  const float mu = sm * (1.f / 128.f);
  float vs = 0.f;
#pragma unroll
  for (int d = 0; d < 4; ++d)
#pragma unroll
    for (int i = 0; i < 16; ++i) { float dlt = hs[d][i] - mu; vs += dlt * dlt; }
  vs += __shfl_xor(vs, 32);
  const float rstd = rsqrtf(vs * (1.f / 128.f) + 1e-5f);
  const float* ng = p.ml_norm_g + (size_t)li_ * 512 + hd * 128;
  const size_t R = R0 + tq;
  if (!dry)
#pragma unroll
  for (int d = 0; d < 4; ++d)
#pragma unroll
    for (int g = 0; g < 4; ++g) {
      const int dv = d * 32 + 8 * g + 4 * hh;
      h16* yp = GY + R * 1024 + hd * 128 + dv;
      const h4 gv = *(const h4*)yp;
      const h4 og = *(const h4*)(OG + R * 512 + hd * 128 + dv);
      h4 ov;
#pragma unroll
      for (int e = 0; e < 4; ++e)
        ov[e] = (h16)((hs[d][4 * g + e] - mu) * rstd * ng[dv + e] * (float)og[e] * (float)gv[e]);
      *(h4*)yp = ov;
    }
}


#undef LOADQ
#define XB_TMO      128
#define XB_XCNT(j)  (256  + 64 * (j))
#define XB_XSUB(j)  (1280 + 64 * (j))
#define XB_XGEN(j)  (2304 + 64 * (j))
#define XB_TOP      3328
#define XB_TOPGEN   3392
#define XCD_BAR_WORDS 3456
#define XB_SPIN_CAP (1u << 22)
#define LAS __attribute__((address_space(3)))
DI unsigned xb_ld(unsigned* p) { return __hip_atomic_load(p, __ATOMIC_RELAXED, __HIP_MEMORY_SCOPE_AGENT); }
DI unsigned xb_add(unsigned* p, unsigned v) { return __hip_atomic_fetch_add(p, v, __ATOMIC_RELAXED, __HIP_MEMORY_SCOPE_AGENT); }
DI unsigned xb_xcc_id() { return (unsigned)__builtin_amdgcn_s_getreg((3 << 11) | 20) & 0xFu; }
#define XB_SPIN(cond, bar) do { unsigned _sp = 0; while (cond) { __builtin_amdgcn_s_sleep(1); \
    if ((++_sp & 255u) == 0u) { if (xb_ld(&(bar)[XB_TMO])) break; if (_sp > XB_SPIN_CAP) { atomicAdd(&(bar)[XB_TMO], 1u); break; } } } } while (0)
struct XcdBarrier { unsigned* bar; unsigned x; volatile LAS unsigned* st; };
DI XcdBarrier xcd_barrier_post(unsigned* bar, volatile LAS unsigned* st) {
  XcdBarrier b; b.bar = bar; b.x = xb_xcc_id(); b.st = st;
  if (threadIdx.x == 0) (void)xb_add(&bar[XB_XCNT(b.x)], 1u);
  return b;
}
DI void xcd_barrier_complete(unsigned* bar, unsigned x, unsigned& nloc, unsigned& nx) {
  const unsigned G = gridDim.x * gridDim.y * gridDim.z;
  unsigned sum, cnt, mine, sp = 0u;
  for (;;) {
    sum = 0u; cnt = 0u; mine = 0u;
#pragma unroll
    for (unsigned j = 0; j < 16; ++j) { const unsigned c = xb_ld(&bar[XB_XCNT(j)]); sum += c; cnt += (c > 0u) ? 1u : 0u; mine = (j == x) ? c : mine; }
    if (sum == G) break;
    __builtin_amdgcn_s_sleep(1);
    if ((++sp & 255u) == 0u) { if (xb_ld(&bar[XB_TMO])) break; if (sp > XB_SPIN_CAP) { atomicAdd(&bar[XB_TMO], 1u); break; } }
  }
  nloc = mine > 0u ? mine : 1u; nx = cnt > 0u ? cnt : 1u;
}
DI void xcd_barrier(const XcdBarrier& b) {
  asm volatile("s_waitcnt vmcnt(0)" ::: "memory");
  __syncthreads();
  if (threadIdx.x == 0) {
    unsigned* bar = b.bar; asm volatile("" : "+s"(bar));
    unsigned bx = b.x; asm volatile("" : "+s"(bx));
    __builtin_amdgcn_s_waitcnt(0);
    unsigned nloc = b.st[0], nx = b.st[1];
    if (nloc == 0u) { xcd_barrier_complete(bar, bx, nloc, nx); b.st[0] = nloc; b.st[1] = nx; }
    const unsigned old = xb_add(&bar[XB_XSUB(bx)], 1u);
    const unsigned gen = old / nloc;
    if (old + 1u == (gen + 1u) * nloc) {
      __builtin_amdgcn_fence(__ATOMIC_RELEASE, "agent");
      asm volatile("s_waitcnt vmcnt(0)" ::: "memory");
      const unsigned og = xb_add(&bar[XB_TOP], 1u);
      const unsigned tg = og / nx;
      if (og + 1u == (tg + 1u) * nx) xb_add(&bar[XB_TOPGEN], 1u);
      else XB_SPIN(xb_ld(&bar[XB_TOPGEN]) == tg, bar);
      __builtin_amdgcn_fence(__ATOMIC_ACQUIRE, "agent");
      xb_add(&bar[XB_XGEN(bx)], 1u);
      asm volatile("s_waitcnt vmcnt(0)" ::: "memory");
    } else {
      XB_SPIN(xb_ld(&bar[XB_XGEN(bx)]) == gen, bar);
      __builtin_amdgcn_fence(__ATOMIC_ACQUIRE, "agent");
      asm volatile("s_waitcnt vmcnt(0)" ::: "memory");
    }
  }
  __syncthreads();
}

__global__ void __launch_bounds__(256, 2) fwd_megakernel(Params p) {
  cg::grid_group grid = cg::this_grid();
  __shared__ __attribute__((aligned(16))) char smem[74240];
  char* ws = p.ws;
  const int tid = threadIdx.x, lane = tid & 63, w = tid >> 6;
  const int nblk = gridDim.x, bid = blockIdx.x;

  h16* WEV = (h16*)(ws + OFF_WEV);
  h16* WOD = (h16*)(ws + OFF_WOD);
  h16* WOUT = (h16*)(ws + OFF_WOUT);
  h16* WUQ = (h16*)(ws + OFF_WUQ);
  h16* WUKV = (h16*)(ws + OFF_WUKV);
  float* MOD = (float*)(ws + OFF_MOD);
  float* RDA = (float*)(ws + OFF_RDA);
  float* RML = (float*)(ws + OFF_RML);
  h16* X16 = (h16*)(ws + OFF_X16);
  h16* GY = (h16*)(ws + OFF_GY);
  h16* H = (h16*)(ws + OFF_H);
  h16* T = (h16*)(ws + OFF_T);

  __shared__ uint4 xb_words;
  unsigned* xbar = (unsigned*)(ws + OFF_BAR);
  if (tid == 0) xb_words = make_uint4(0u, 0u, 0u, 0u);
  if (bid == 0) for (int i = tid; i < XCD_BAR_WORDS; i += 256) xbar[i] = 0u;
  __syncthreads();
  {
    constexpr int N_ADA = 192;
    constexpr int T_EV = 16 * 48, T_OD = 16 * 76, T_OUT = 256, T_UQ = 4 * 12, T_UKV = 2 * 16;
    constexpr int N_TR = 2 * T_EV + 2 * T_OD + 4 * T_OUT + 2 * T_UQ + 2 * T_UKV;
    float* lds = (float*)smem;
    for (int it = bid; it < N_ADA + N_TR; it += nblk) {
      if (it < N_ADA) {
        float* scond = lds;
        float* red = lds + 5120;
        for (int idx = tid; idx < 5120; idx += 256) {
          const int rr = idx >> 10, d = idx & 1023;
          const float v = rr < 4 ? p.c[rr * 1024 + d] : p.c_ctx[d];
          scond[idx] = silu_f(v);
        }
        __syncthreads();
        const int col = it * 64 + (tid & 63), q = tid >> 6;
        const int l = col / 3072, e = col - l * 3072;
        const float* wp = p.ada_w + (size_t)l * 1024 * 3072 + e;
        float a0 = 0, a1 = 0, a2 = 0, a3 = 0, a4 = 0;
        for (int d = q * 256; d < q * 256 + 256; ++d) {
          const float wv = wp[(size_t)d * 3072];
          a0 += scond[d] * wv; a1 += scond[1024 + d] * wv; a2 += scond[2048 + d] * wv;
          a3 += scond[3072 + d] * wv; a4 += scond[4096 + d] * wv;
        }
        red[(q * 5 + 0) * 64 + (tid & 63)] = a0; red[(q * 5 + 1) * 64 + (tid & 63)] = a1;
        red[(q * 5 + 2) * 64 + (tid & 63)] = a2; red[(q * 5 + 3) * 64 + (tid & 63)] = a3;
        red[(q * 5 + 4) * 64 + (tid & 63)] = a4;
        __syncthreads();
        for (int idx = tid; idx < 320; idx += 256) {
          const int rr = idx >> 6, cc = idx & 63;
          const float s = red[(0 * 5 + rr) * 64 + cc] + red[(1 * 5 + rr) * 64 + cc] + red[(2 * 5 + rr) * 64 + cc] + red[(3 * 5 + rr) * 64 + cc];
          const int col2 = it * 64 + cc, l2 = col2 / 3072, e2 = col2 - l2 * 3072;
          MOD[((size_t)l2 * 5 + rr) * 3072 + e2] = s + p.ada_b[l2 * 3072 + e2];
        }
        __syncthreads();
      } else {
        int t = it - N_ADA;
        const float* W; h16* Wt; int K, N, Npad; const float* gk = nullptr;
        if (t < 2 * T_EV) { int i = t / T_EV; t -= i * T_EV; W = p.ev_w_in + (size_t)i * 1024 * EV_IN; Wt = WEV + (size_t)i * EV_INP * 1024; K = 1024; N = EV_IN; Npad = EV_INP; }
        else if ((t -= 2 * T_EV) < 2 * T_OD) { int i = t / T_OD; t -= i * T_OD; W = p.od_w_in + (size_t)i * 1024 * OD_IN; Wt = WOD + (size_t)i * OD_INP * 1024; K = 1024; N = OD_IN; Npad = OD_INP; }
        else if ((t -= 2 * T_OD) < 4 * T_OUT) { int l = t / T_OUT; t -= l * T_OUT; W = ((l & 1) ? p.od_w_out : p.ev_w_out) + (size_t)(l >> 1) * 1024 * 1024; Wt = WOUT + (size_t)l * 1024 * 1024; K = 1024; N = 1024; Npad = 1024; }
        else if ((t -= 4 * T_OUT) < 2 * T_UQ) { int i = t / T_UQ; t -= i * T_UQ; W = p.mla_w_uq + (size_t)i * 256 * 768; Wt = WUQ + (size_t)i * 768 * 256; K = 256; N = 768; Npad = 768; gk = p.mla_q_norm_g + i * 256; }
        else { t -= 2 * T_UQ; int i = t / T_UKV; t -= i * T_UKV; W = p.mla_w_ukv + (size_t)i * 128 * 1024; Wt = WUKV + (size_t)i * 1024 * 128; K = 128; N = 1024; Npad = 1024; gk = p.mla_kv_norm_g + i * 128; }
        const int nK = K >> 6;
        const int kt = t % nK, nt = t / nK, k0 = kt * 64, n0 = nt * 64;
        const int cc = tid & 63, r4 = tid >> 6;
#pragma unroll 4
        for (int i = 0; i < 16; ++i) {
          const int rr = r4 + 4 * i, n = n0 + cc;
          float v = 0.f;
          if (n < N) { v = W[(size_t)(k0 + rr) * N + n]; if (gk) v *= gk[k0 + rr]; }
          lds[rr * 65 + cc] = v;
        }
        __syncthreads();
#pragma unroll 4
        for (int i = 0; i < 16; ++i) {
          const int rr = r4 + 4 * i;
          Wt[(size_t)(n0 + rr) * K + k0 + cc] = (h16)lds[cc * 65 + rr];
        }
        __syncthreads();
      }
    }
    for (int idx = bid * 256 + tid; idx < SEQ * 48; idx += nblk * 256) {
      const int s = idx / 48, i = idx - s * 48;
      const int grow = s >> 6, gcol = s & 63;
      float ang;
      float* dst;
      if (i < 32) {
        const int f = i & 15;
        const float fr = expf(-(float)f * (9.210340371976184f / 16.f));
        ang = (float)(i < 16 ? grow : gcol) * fr;
        dst = RDA + ((size_t)s * 32 + i) * 2;
      } else {
        const int ii = i - 32, f = ii & 7;
        const float fr = expf(-(float)f * (9.210340371976184f / 8.f));
        ang = (float)(ii < 8 ? grow : gcol) * fr;
        dst = RML + ((size_t)s * 16 + ii) * 2;
      }
      const float kf = rintf(ang * 0.15915494309189535f);
      float rr = fmaf(-kf, 6.28125f, ang);
      rr = fmaf(-kf, 1.9353071795864769e-3f, rr);
      dst[0] = cosf(rr);
      dst[1] = sinf(rr);
    }
  }
  grid.sync();
  const XcdBarrier xb = xcd_barrier_post(xbar, (volatile LAS unsigned*)&xb_words);
#ifdef NSYNC_EXTRA
  for (int i_ = 0; i_ < NSYNC_EXTRA; ++i_) xcd_barrier(xb);
#endif
  for (int idx = bid * 256 + tid; idx < NR * 128; idx += nblk * 256) {
    const int R = idx >> 7, c8 = (idx & 127) * 8;
    const int b = R / TB, j = R - b * TB;
    const float* xr = in_row(p, R) + c8;
    const float* md = MOD + (size_t)(j < SEQ ? b : 4) * 3072;
    const float4 x0 = *(const float4*)xr, x1 = *(const float4*)(xr + 4);
    const float4 s0 = *(const float4*)(md + c8), s1 = *(const float4*)(md + c8 + 4);
    const float4 c0 = *(const float4*)(md + 1024 + c8), c1 = *(const float4*)(md + 1024 + c8 + 4);
    h8 o;
    o[0] = (h16)(x0.x * (1.f + c0.x) + s0.x); o[1] = (h16)(x0.y * (1.f + c0.y) + s0.y);
    o[2] = (h16)(x0.z * (1.f + c0.z) + s0.z); o[3] = (h16)(x0.w * (1.f + c0.w) + s0.w);
    o[4] = (h16)(x1.x * (1.f + c1.x) + s1.x); o[5] = (h16)(x1.y * (1.f + c1.y) + s1.y);
    o[6] = (h16)(x1.z * (1.f + c1.z) + s1.z); o[7] = (h16)(x1.w * (1.f + c1.w) + s1.w);
    *(h8*)(H + (size_t)R * 1024 + c8) = o;
  }
  xcd_barrier(xb);

#pragma unroll 1
  for (int layer = 0; layer < 4; ++layer) {
    asm volatile("" : "+s"(ws));
    h16* WEV = (h16*)(ws + OFF_WEV);
    h16* WOD = (h16*)(ws + OFF_WOD);
    h16* WOUT = (h16*)(ws + OFF_WOUT);
    h16* WUQ = (h16*)(ws + OFF_WUQ);
    h16* WUKV = (h16*)(ws + OFF_WUKV);
    float* MOD = (float*)(ws + OFF_MOD);
    float* RDA = (float*)(ws + OFF_RDA);
    float* RML = (float*)(ws + OFF_RML);
    h16* X16 = (h16*)(ws + OFF_X16);
    h16* GY = (h16*)(ws + OFF_GY);
    h16* H = (h16*)(ws + OFF_H);
    h16* T = (h16*)(ws + OFF_T);
    const int li_ = layer >> 1;
    const bool upd = layer < 3;
    if ((layer & 1) == 0) {
      {
        EpiEven epi{p.ev_b_in + (size_t)li_ * EV_IN, RDA, RML, (h16*)(ws + OFF_QK4), (h16*)(ws + OFF_VT),
                    (h16*)(ws + OFF_CQKV), (h16*)(ws + OFF_KR), GY};
        const h16* Bt = WEV + (size_t)li_ * EV_INP * 1024;
        constexpr int NT = EV_INP / 128;
        constexpr int NTW = NT / 2;
        for (int it = bid; it < 264 * NTW; it += nblk) {
          const int x = it & 7, q = it >> 3;
          const int mt = 33 * x + q / NTW, nt = q % NTW;
          gemm_tile_w(H, 1024, Bt, 1024, 1024, mt * 128, nt * 256, smem, epi);
        }
      }
      xcd_barrier(xb);
      {
        int tid = threadIdx.x; asm volatile("" : "+v"(tid)); const int lane = tid & 63, w = tid >> 6; (void)lane; (void)w;
        const h16* CQKV = (const h16*)(ws + OFF_CQKV);
        float* rstd = (float*)(smem + 73728);
#pragma unroll 1
        for (int rep_ = 0; rep_ < NREP_GEMM; ++rep_)
        for (int it = bid; it < 264 * 14; it += nblk) {
          const int mt = it / 14, nt = it - mt * 14;
          const int row0 = mt * 128;
          const bool uq = nt < 6;
          {
            const int rr = tid >> 1, hs = tid & 1;
            const h16* src = CQKV + (size_t)(row0 + rr) * 384 + (uq ? hs * 128 : 256 + hs * 64);
            float ss = 0.f;
            const int n8 = uq ? 16 : 8;
            for (int q = 0; q < n8; ++q) {
              const h8 v = *(const h8*)(src + q * 8);
#pragma unroll
              for (int e = 0; e < 8; ++e) ss += (float)v[e] * (float)v[e];
            }
            ss += __shfl_xor(ss, 1);
            if (hs == 0) rstd[rr] = rsqrtf(ss * (uq ? 1.f / 256.f : 1.f / 128.f) + 1e-6f);
          }
          __syncthreads();
          if (uq) {
            EpiUQ epi{rstd, row0, RML, (h16*)(ws + OFF_QM)};
            gemm_tile(CQKV, 384, WUQ + (size_t)li_ * 768 * 256, 256, 256, row0, nt * 128, smem, epi);
          } else {
            EpiUKV epi{rstd, row0, (h16*)(ws + OFF_KN), (h16*)(ws + OFF_VMT)};
            gemm_tile(CQKV + 256, 384, WUKV + (size_t)li_ * 1024 * 128, 128, 128, row0, (nt - 6) * 128, smem, epi);
          }
          __syncthreads();
        }
      }
      xcd_barrier(xb);
      {
        int tid = threadIdx.x; asm volatile("" : "+v"(tid)); const int lane = tid & 63, w = tid >> 6; (void)lane; (void)w;
        const float lam_init = 0.8f - 0.6f * expf(-0.3f * (float)layer);
        float lam;
        {
          const float* dl = p.da_lambda + (size_t)li_ * 256;
          float s1 = dl[lane] * dl[64 + lane], s2 = dl[128 + lane] * dl[192 + lane];
#pragma unroll
          for (int off = 32; off > 0; off >>= 1) { s1 += __shfl_xor(s1, off); s2 += __shfl_xor(s2, off); }
          lam = expf(s1) - expf(s2) + lam_init;
        }
        constexpr int N_DA = 1024, N_MLA = 1024, N_DAC = 32, N_MLAC = 32;
#ifndef NREP_E4
#define NREP_E4 1
#endif
#pragma unroll 1
        for (int rep = 0; rep < NREP_E4; ++rep) {
        int dry = (rep + 1 < NREP_E4); asm volatile("" : "+s"(dry));
        for (int it = bid; it < N_DA + N_MLA + N_DAC + N_MLAC; it += nblk) {
          if (it < N_DA) {
            const int rd = it >> 9, pair = rd * 8 + (it & 7), qt = (it & 511) >> 3, hd = pair & 3, b = pair >> 2;

#ifndef SKIP_DA
            da_item(p, layer, b, hd, qt * 128, 0, 132, lam, lam_init, smem, dry);
#endif

          } else if (it < N_DA + N_MLA) {
            const int t = it - N_DA;
            const int rd = t >> 9, x = t & 7, slot = (t & 511) >> 3;
            const int pair = rd * 16 + x * 2 + (slot >> 5), qt = slot & 31, hd = pair & 7, b = pair >> 3;

#ifndef SKIP_MLA
            mla_item(p, b, hd, qt * 256, 0, 132, smem, dry);
#endif

          } else if (it < N_DA + N_MLA + N_DAC) {
            const int t = it - N_DA - N_MLA;
            const int qt = t & 1, hd = (t >> 1) & 3, b = t >> 3;

#ifndef SKIP_DA
            da_item(p, layer, b, hd, SEQ + qt * 128, 128, 132, lam, lam_init, smem, dry);
#endif

          } else {
            const int t = it - N_DA - N_MLA - N_DAC;
            const int hd = t & 7, b = t >> 3;

#ifndef SKIP_MLA
            mla_item(p, b, hd, SEQ, 128, 132, smem, dry);
#endif

          }
        }
        }
      }
      xcd_barrier(xb);

    } else {
      {
        EpiOdd epi{p.od_b_in + (size_t)li_ * OD_IN, (h16*)(ws + OFF_QKP), (h16*)(ws + OFF_MVT), (h16*)(ws + OFF_OG),
                   (h16*)(ws + OFF_NAQ), (h16*)(ws + OFF_NAK), (h16*)(ws + OFF_NAVT), GY, (float*)(ws + OFF_GT)};
        const h16* Bt = WOD + (size_t)li_ * OD_INP * 1024;
        constexpr int NT = OD_INP / 128;
        constexpr int NTW = NT / 2;
        for (int it = bid; it < 264 * NTW; it += nblk) {
          const int x = it & 7, q = it >> 3;
          const int mt = 33 * x + q / NTW, nt = q % NTW;
          gemm_tile_w(H, 1024, Bt, 1024, 1024, mt * 128, nt * 256, smem, epi);
        }
      }
      xcd_barrier(xb);
      {
        int tid = threadIdx.x; asm volatile("" : "+v"(tid)); const int lane = tid & 63, w = tid >> 6; (void)lane; (void)w;
        constexpr int N_M1 = NCHAIN * NCHUNK, N_NA = 4 * 128 * 4;
        const int n_nac = upd ? 64 : 0;
#ifndef NREP_O2
#define NREP_O2 1
#endif
#pragma unroll 1
        for (int rep = 0; rep < NREP_O2; ++rep) {
        int dry = (rep + 1 < NREP_O2); asm volatile("" : "+s"(dry));
        constexpr int N_NA_O2 = 448;
        for (int it = bid; it < N_M1 + N_NA_O2; it += nblk) {
          if (it < N_M1) {

#ifndef SKIP_M1
            m1_item(p, layer, it / NCHUNK, it % NCHUNK, smem);
#endif

          } else {
            const int t = it - N_M1;
            const int hp = t & 3, gr = (t >> 2) & 127, b = t >> 9;

#ifndef SKIP_NA
            na_wave(p, layer, b, gr, hp, smem, dry);
#endif

          }
        }
        }
        (void)N_NA; (void)n_nac;
      }
      xcd_barrier(xb);
      {
        int tid = threadIdx.x; asm volatile("" : "+v"(tid)); const int lane = tid & 63, w = tid >> 6; (void)lane; (void)w;
        h16* UT = (h16*)(ws + OFF_H);
        const float* BT = (const float*)(ws + OFF_BT);
        const float* GM = (const float*)(ws + OFF_GM);
        float* MP = (float*)(ws + OFF_MP);
        float* NL = (float*)(ws + OFF_NL);
        for (int idx = bid * 256 + tid; idx < NCHAIN * 4096 + NCHAIN * 128; idx += nblk * 256) {
          if (idx < NCHAIN * 4096) {
            const int c = idx >> 12, e = (idx & 4095) * 4;
            float m = 0.f, C0 = 0.f, C1 = 0.f, C2 = 0.f, C3 = 0.f;
            h16* ub = UT + (size_t)c * NCHUNK * 16384 + e;
#pragma unroll 1
            for (int k0 = 0; k0 < NCHUNK; k0 += 6) {
              h4 u[6];
#pragma unroll
              for (int j = 0; j < 6; ++j) u[j] = *(const h4*)(ub + (size_t)(k0 + j) * 16384);
#pragma unroll
              for (int j = 0; j < 6; ++j) {
                const int k = k0 + j;
                const float bt = BT[c * NCHUNK + k], gm = GM[c * NCHUNK + k];
                const float mn = fmaxf(bt + m, gm);
                const float decay = __expf(bt + m - mn), sc = __expf(gm - mn);
                h4 cv; cv[0] = (h16)C0; cv[1] = (h16)C1; cv[2] = (h16)C2; cv[3] = (h16)C3;
                *(h4*)(ub + (size_t)k * 16384) = cv;
                if (e == 0) MP[c * NCHUNK + k] = m;
                C0 = decay * C0 + sc * (float)u[j][0]; C1 = decay * C1 + sc * (float)u[j][1];
                C2 = decay * C2 + sc * (float)u[j][2]; C3 = decay * C3 + sc * (float)u[j][3];
                m = mn;
              }
            }
          } else {
            const int q = idx - NCHAIN * 4096;
            const int c = q >> 7, e = q & 127;
            float m = 0.f, C = 0.f;
            float* nb = NL + (size_t)c * NCHUNK * 128 + e;
#pragma unroll 1
            for (int k0 = 0; k0 < NCHUNK; k0 += 6) {
              float u[6];
#pragma unroll
              for (int j = 0; j < 6; ++j) u[j] = nb[(k0 + j) * 128];
#pragma unroll
              for (int j = 0; j < 6; ++j) {
                const int k = k0 + j;
                const float bt = BT[c * NCHUNK + k], gm = GM[c * NCHUNK + k];
                const float mn = fmaxf(bt + m, gm);
                const float decay = __expf(bt + m - mn), sc = __expf(gm - mn);
                nb[k * 128] = C;
                C = decay * C + sc * u[j];
                m = mn;
              }
            }
          }
        }
      }
      xcd_barrier(xb);
      {
        const int nkc = upd ? 66 : 64;
#ifndef NREP_M3
#define NREP_M3 1
#endif
#pragma unroll 1
        for (int rep = 0; rep < NREP_M3; ++rep) {
        int dry = (rep + 1 < NREP_M3); asm volatile("" : "+s"(dry));
        for (int it = bid; it < 16 * nkc; it += nblk) {
          const int kc = it % nkc, bh = it / nkc;

#ifndef SKIP_M3
          m3_item(p, layer, bh >> 2, bh & 3, kc, smem, dry);
#endif

        }
        {
          int tid = threadIdx.x; asm volatile("" : "+v"(tid)); const int w = tid >> 6;
          const int n_rest = (2048 - 448) + (upd ? 64 : 0);
          const int nskip = (upd && nblk > 64) ? 32 : 0;
          for (int j = (bid >= nskip ? bid - nskip : n_rest); j < n_rest; j += nblk - nskip) {
            if (j < 2048 - 448) {
              const int t = 448 + j;
              const int hp = t & 3, gr = (t >> 2) & 127, b = t >> 9;
              na_wave(p, layer, b, gr, hp, smem, dry);
            } else {
              const int t = j - (2048 - 448);
              nactx_item(p, t >> 4, (t >> 1) & 7, t & 1, dry);
            }
          }
        }
        }
      }
      xcd_barrier(xb);
    }
    {
      EpiOut epi{p.x, p.ctx, layer, MOD, X16, T};
      const h16* Bt = WOUT + (size_t)layer * 1024 * 1024;
#pragma unroll 1
      for (int rep_ = 0; rep_ < NREP_GEMM; ++rep_)
      for (int it = bid; it < 5 * 512; it += nblk) {
        const int sup = (it >> 9) * 8 + (it & 7), slot = (it & 511) >> 3;
        if (sup >= 33) continue;
        const int mt = sup * 8 + (slot >> 3), nt = slot & 7;
        if (!upd && (mt % 66) >= 64) continue;
        gemm_tile(GY, 1024, Bt, 1024, 1024, mt * 128, nt * 128, smem, epi);
      }
    }
    xcd_barrier(xb);
    {
      int tid2 = threadIdx.x; asm volatile("" : "+v"(tid2));
      const int lane = tid2 & 63, w = tid2 >> 6;
      const float* lg = p.ln_g + layer * 1024;
      const float* lb = p.ln_b + layer * 1024;
      for (int R = bid * 4 + w; R < NR; R += nblk * 4) {
        const int b = R / TB, j = R - b * TB;
        if (!upd && j >= SEQ) continue;
        const h16* tr = T + (size_t)R * 1024;
        float4 v[4];
        float s = 0.f;
#pragma unroll
        for (int q = 0; q < 4; ++q) {
          const h4 th = *(const h4*)(tr + q * 256 + lane * 4);
          v[q].x = (float)th[0]; v[q].y = (float)th[1]; v[q].z = (float)th[2]; v[q].w = (float)th[3];
          s += v[q].x + v[q].y + v[q].z + v[q].w;
        }
#pragma unroll
        for (int off = 32; off > 0; off >>= 1) s += __shfl_xor(s, off);
        const float mu = s * (1.f / 1024.f);
        float vs = 0.f;
#pragma unroll
        for (int q = 0; q < 4; ++q) {
          v[q].x -= mu; v[q].y -= mu; v[q].z -= mu; v[q].w -= mu;
          vs += v[q].x * v[q].x + v[q].y * v[q].y + v[q].z * v[q].z + v[q].w * v[q].w;
        }
#pragma unroll
        for (int off = 32; off > 0; off >>= 1) vs += __shfl_xor(vs, off);
        const float rstd = rsqrtf(vs * (1.f / 1024.f) + 1e-5f);
        const float* md = MOD + ((size_t)(layer + 1) * 5 + (j < SEQ ? b : 4)) * 3072;
#pragma unroll
        for (int q = 0; q < 4; ++q) {
          const int col = q * 256 + lane * 4;
          const float4 g4 = *(const float4*)(lg + col), b4 = *(const float4*)(lb + col);
          float4 xo;
          xo.x = v[q].x * rstd * g4.x + b4.x; xo.y = v[q].y * rstd * g4.y + b4.y;
          xo.z = v[q].z * rstd * g4.z + b4.z; xo.w = v[q].w * rstd * g4.w + b4.w;
          if (upd) {
            h4 xh; xh[0] = (h16)xo.x; xh[1] = (h16)xo.y; xh[2] = (h16)xo.z; xh[3] = (h16)xo.w;
            *(h4*)(X16 + (size_t)R * 1024 + col) = xh;
            const float4 sh = *(const float4*)(md + col), sc = *(const float4*)(md + 1024 + col);
            h4 hh4;
            hh4[0] = (h16)(xo.x * (1.f + sc.x) + sh.x); hh4[1] = (h16)(xo.y * (1.f + sc.y) + sh.y);
            hh4[2] = (h16)(xo.z * (1.f + sc.z) + sh.z); hh4[3] = (h16)(xo.w * (1.f + sc.w) + sh.w);
            *(h4*)(H + (size_t)R * 1024 + col) = hh4;
          } else {
            *(float4*)(p.out + ((size_t)b * SEQ + j) * 1024 + col) = xo;
          }
        }
      }
    }
    if (layer < 3) xcd_barrier(xb);
  }
}

extern "C" void kernel_launch(void* const* d_in, const int* in_sizes, int n_in, void* d_out, int out_size, void* d_ws,
                              size_t ws_size, hipStream_t stream) {
  static int grid_blocks = 0;
  if (!grid_blocks) {
    int dev = 0, cus = 0, per_cu = 0;
    hipGetDevice(&dev);
    hipDeviceGetAttribute(&cus, hipDeviceAttributeMultiprocessorCount, dev);
    hipOccupancyMaxActiveBlocksPerMultiprocessor(&per_cu, fwd_megakernel, 256, 0);
    if (per_cu > 2) per_cu = 2;
    if (per_cu < 1) per_cu = 1;
    grid_blocks = cus * per_cu;
  }
  Params p{};
  const float** pp = (const float**)&p;
  for (int i = 0; i < 25; ++i) pp[i] = (const float*)d_in[i];
  p.out = (float*)d_out;
  p.ws = (char*)d_ws;
  void* args[] = {&p};
  hipError_t e = hipLaunchCooperativeKernel((void*)fwd_megakernel, dim3(grid_blocks), dim3(256), args, 0, stream);
  if (e != hipSuccess) fprintf(stderr, "cooperative launch failed: %s (grid %d)\n", hipGetErrorString(e), grid_blocks);
}
```

```cpp
#include <hip/hip_runtime.h>
#include <hip/hip_cooperative_groups.h>
#include <cstdio>
namespace cg = cooperative_groups;

typedef _Float16 h16;
typedef __attribute__((ext_vector_type(8))) _Float16 h8;
typedef __attribute__((ext_vector_type(4))) _Float16 h4;
typedef __attribute__((ext_vector_type(16))) float f16v;
#define MFMA(a, b, c) __builtin_amdgcn_mfma_f32_32x32x16_f16((a), (b), (c), 0, 0, 0)
#define DI __device__ __forceinline__

constexpr int NB = 4, SEQ = 8192, CTXL = 256, TB = 8448, NR = NB * TB, DM = 1024;
constexpr int EV_IN = 2976, EV_INP = 3072, OD_IN = 4624, OD_INP = 4864;
constexpr int NCHAIN = 32, NCHUNK = 66;
constexpr float LOG2E = 1.4426950408889634f;
constexpr float DN_ALPHA = 1.681792830507429f;

constexpr size_t al256(size_t x) { return (x + 255) & ~(size_t)255; }
constexpr size_t OFF_WEV = 0;
constexpr size_t OFF_WOD = OFF_WEV + al256(2ull * EV_INP * 1024 * 2);
constexpr size_t OFF_WOUT = OFF_WOD + al256(2ull * OD_INP * 1024 * 2);
constexpr size_t OFF_WUQ = OFF_WOUT + al256(4ull * 1024 * 1024 * 2);
constexpr size_t OFF_WUKV = OFF_WUQ + al256(2ull * 768 * 256 * 2);
constexpr size_t OFF_MOD = OFF_WUKV + al256(2ull * 1024 * 128 * 2);
constexpr size_t OFF_RDA = OFF_MOD + al256(4ull * 5 * 3072 * 4);
constexpr size_t OFF_RML = OFF_RDA + al256(8192ull * 32 * 2 * 4);
constexpr size_t OFF_BT = OFF_RML + al256(8192ull * 16 * 2 * 4);
constexpr size_t OFF_GM = OFF_BT + al256(NCHAIN * NCHUNK * 4);
constexpr size_t OFF_MP = OFF_GM + al256(NCHAIN * NCHUNK * 4);
constexpr size_t OFF_NL = OFF_MP + al256(NCHAIN * NCHUNK * 4);
constexpr size_t OFF_BAR = OFF_NL + al256((size_t)NCHAIN * NCHUNK * 128 * 4);
constexpr size_t OFF_X16 = OFF_BAR + 16384;
constexpr size_t SZ_ACT = (size_t)NR * 1024 * 2;
constexpr size_t OFF_GY = OFF_X16 + SZ_ACT;
constexpr size_t OFF_H = OFF_GY + SZ_ACT;
constexpr size_t OFF_SCR = OFF_H + SZ_ACT;
constexpr size_t OFF_T = OFF_SCR;
constexpr size_t OFF_QK4 = OFF_SCR;
constexpr size_t OFF_VT = OFF_QK4 + SZ_ACT;
constexpr size_t OFF_CQKV = OFF_VT + (size_t)NB * 512 * TB * 2;
constexpr size_t OFF_KR = OFF_CQKV + (size_t)NR * 384 * 2;
constexpr size_t OFF_QM = OFF_KR + (size_t)NR * 32 * 2;
constexpr size_t OFF_KN = OFF_QM + (size_t)NR * 768 * 2;
constexpr size_t OFF_VMT = OFF_KN + (size_t)NR * 512 * 2;
constexpr size_t END_EVEN = OFF_VMT + (size_t)NB * 512 * TB * 2;
constexpr size_t OFF_QKP = OFF_SCR;
constexpr size_t OFF_MVT = OFF_QKP + SZ_ACT;
constexpr size_t OFF_OG = OFF_MVT + (size_t)NB * 512 * TB * 2;
constexpr size_t OFF_NAQ = OFF_OG + (size_t)NR * 512 * 2;
constexpr size_t OFF_NAK = OFF_NAQ + (size_t)NR * 512 * 2;
constexpr size_t OFF_NAVT = OFF_NAK + (size_t)NR * 512 * 2;
constexpr size_t OFF_GT = OFF_NAVT + (size_t)NB * 512 * TB * 2;
constexpr size_t END_ODD = OFF_GT + (size_t)NR * 16 * 4;
constexpr size_t WS_NEED = END_EVEN > END_ODD ? END_EVEN : END_ODD;
static_assert(WS_NEED <= 536870912ull, "workspace too big");
static_assert(OFF_QKP + SZ_ACT + 2 * (size_t)NB * 512 * TB * 2 >= OFF_T + (size_t)NR * 1024 * 4, "T alias odd");

#ifndef NREP_GEMM
#define NREP_GEMM 1
#endif
struct Params {
  const float *x, *c, *ctx, *c_ctx, *ada_w, *ada_b, *ln_g, *ln_b, *ev_w_in, *ev_b_in, *da_lambda, *da_subln_g,
      *mla_q_norm_g, *mla_kv_norm_g, *mla_w_uq, *mla_w_ukv, *ev_w_out, *od_w_in, *od_b_in, *ml_conv_w, *ml_conv_b,
      *ml_f_bias, *ml_norm_g, *na_rpb, *od_w_out;
  float* out;
  char* ws;
};

DI int crow(int i, int hh) { return (i & 3) + 8 * (i >> 2) + 4 * hh; }
DI float silu_f(float v) { return v / (1.f + __expf(-v)); }
DI float sigmoid_f(float v) { return 1.f / (1.f + __expf(-v)); }
DI float logsig_f(float v) { return fminf(v, 0.f) - log1pf(__expf(-fabsf(v))); }
DI float xhalf_max(float x) {
  const unsigned u = __float_as_uint(x);
  auto rr = __builtin_amdgcn_permlane32_swap(u, u, false, false);
  return fmaxf(__uint_as_float(rr[0]), __uint_as_float(rr[1]));
}
DI float xhalf_sum(float x) {
  const unsigned u = __float_as_uint(x);
  auto rr = __builtin_amdgcn_permlane32_swap(u, u, false, false);
  return __uint_as_float(rr[0]) + __uint_as_float(rr[1]);
}
DI h8 cat44(h4 a, h4 b) { return __builtin_shufflevector(a, b, 0, 1, 2, 3, 4, 5, 6, 7); }
DI f16v zero16() { f16v z;
#pragma unroll
  for (int i = 0; i < 16; ++i) z[i] = 0.f; return z; }

DI const float* in_row(const Params& p, int R) {
  int b = R / TB, j = R - b * TB;
  return j < SEQ ? p.x + ((size_t)b * SEQ + j) * DM : p.ctx + ((size_t)b * CTXL + (j - SEQ)) * DM;
}

template <class Epi>
DI void gemm_tile(const h16* __restrict__ A, int lda, const h16* __restrict__ Bt, int ldb, int K, int row0, int col0,
                  char* smem, const Epi& epi) {
  h16* As = (h16*)smem;
  h16* Bs = As + 128 * 72;
  int tid = threadIdx.x; asm volatile("" : "+v"(tid));
  const int lane = tid & 63, w = tid >> 6, wm = w >> 1, wn = w & 1, r = lane & 31, hh = lane >> 5;
  f16v acc00 = zero16(), acc01 = zero16(), acc10 = zero16(), acc11 = zero16();
  const int lr = tid >> 3, lc = (tid & 7) * 8;
  const h16* Ap = A + (size_t)(row0 + lr) * lda + lc;
  const h16* Bp = Bt + (size_t)(col0 + lr) * ldb + lc;
  const size_t sa = (size_t)32 * lda, sb = (size_t)32 * ldb;
  uint4 ra0, ra1, ra2, ra3, rb0, rb1, rb2, rb3;
  uint4 sa0, sa1, sa2, sa3, sb0, sb1, sb2, sb3;
#define GLOAD(K0)                                                                                   \
  ra0 = *(const uint4*)(Ap + (K0)); ra1 = *(const uint4*)(Ap + sa + (K0));                          \
  ra2 = *(const uint4*)(Ap + 2 * sa + (K0)); ra3 = *(const uint4*)(Ap + 3 * sa + (K0));             \
  rb0 = *(const uint4*)(Bp + (K0)); rb1 = *(const uint4*)(Bp + sb + (K0));                          \
  rb2 = *(const uint4*)(Bp + 2 * sb + (K0)); rb3 = *(const uint4*)(Bp + 3 * sb + (K0));
#define GLOADB(K0)                                                                                  \
  sa0 = *(const uint4*)(Ap + (K0)); sa1 = *(const uint4*)(Ap + sa + (K0));                          \
  sa2 = *(const uint4*)(Ap + 2 * sa + (K0)); sa3 = *(const uint4*)(Ap + 3 * sa + (K0));             \
  sb0 = *(const uint4*)(Bp + (K0)); sb1 = *(const uint4*)(Bp + sb + (K0));                          \
  sb2 = *(const uint4*)(Bp + 2 * sb + (K0)); sb3 = *(const uint4*)(Bp + 3 * sb + (K0));
#define SWRITE(ST)                                                                                  \
  { h16* as_ = As + (ST) * 18432 + lr * 72 + lc; h16* bs_ = Bs + (ST) * 18432 + lr * 72 + lc;       \
  *(uint4*)(as_) = ra0; *(uint4*)(as_ + 32 * 72) = ra1;                                             \
  *(uint4*)(as_ + 64 * 72) = ra2; *(uint4*)(as_ + 96 * 72) = ra3;                                   \
  *(uint4*)(bs_) = rb0; *(uint4*)(bs_ + 32 * 72) = rb1;                                             \
  *(uint4*)(bs_ + 64 * 72) = rb2; *(uint4*)(bs_ + 96 * 72) = rb3; }
#define SWRITEB(ST)                                                                                 \
  { h16* as_ = As + (ST) * 18432 + lr * 72 + lc; h16* bs_ = Bs + (ST) * 18432 + lr * 72 + lc;       \
  *(uint4*)(as_) = sa0; *(uint4*)(as_ + 32 * 72) = sa1;                                             \
  *(uint4*)(as_ + 64 * 72) = sa2; *(uint4*)(as_ + 96 * 72) = sa3;                                   \
  *(uint4*)(bs_) = sb0; *(uint4*)(bs_ + 32 * 72) = sb1;                                             \
  *(uint4*)(bs_ + 64 * 72) = sb2; *(uint4*)(bs_ + 96 * 72) = sb3; }
#define GCOMPUTE(ST)                                                                                \
  { const h16* Ac = As + (ST) * 18432; const h16* Bc = Bs + (ST) * 18432; __builtin_amdgcn_s_setprio(1); \
    _Pragma("unroll") for (int kk = 0; kk < 4; ++kk) {                                              \
      h8 a0 = *(const h8*)(Ac + (wm * 64 + r) * 72 + kk * 16 + hh * 8);                             \
      h8 a1 = *(const h8*)(Ac + (wm * 64 + 32 + r) * 72 + kk * 16 + hh * 8);                        \
      h8 b0 = *(const h8*)(Bc + (wn * 64 + r) * 72 + kk * 16 + hh * 8);                             \
      h8 b1 = *(const h8*)(Bc + (wn * 64 + 32 + r) * 72 + kk * 16 + hh * 8);                        \
      acc00 = MFMA(a0, b0, acc00); acc01 = MFMA(a0, b1, acc01);                                     \
      acc10 = MFMA(a1, b0, acc10); acc11 = MFMA(a1, b1, acc11); } __builtin_amdgcn_s_setprio(0); }
  GLOAD(0)
  SWRITE(0)
  __syncthreads();
  GLOAD(64)
  if (128 < K) { GLOADB(128) }
#pragma unroll 1
  for (int k0 = 0; k0 < K; k0 += 128) {
    SWRITE(1)
    if (k0 + 192 < K) { GLOAD(k0 + 192) }
    GCOMPUTE(0)
    __syncthreads();
    if (k0 + 128 < K) {
      SWRITEB(0)
      if (k0 + 256 < K) { GLOADB(k0 + 256) }
    }
    GCOMPUTE(1)
    __syncthreads();
  }
#undef GLOADB
#undef SWRITEB
#undef GCOMPUTE
#undef GLOAD
#undef SWRITE
  epi.frag(smem, row0 + wm * 64, col0 + wn * 64, wm * 64, wn * 64, acc00, acc01);
  epi.frag(smem, row0 + wm * 64 + 32, col0 + wn * 64, wm * 64 + 32, wn * 64, acc10, acc11);
  __syncthreads();
  epi.copy(smem, row0, col0);
  __syncthreads();
}

constexpr int STG_T_OFF = 34816;
template <class Epi>
DI void gemm_tile_w(const h16* __restrict__ A, int lda, const h16* __restrict__ Bt, int ldb, int K, int row0, int col0,
                    char* smem, const Epi& epi) {
  h16* As = (h16*)smem;
  h16* Bs = As + 128 * 40;
  int tid = threadIdx.x; asm volatile("" : "+v"(tid));
  const int lane = tid & 63, w = tid >> 6, wm = w >> 1, wn = w & 1, r = lane & 31, hh = lane >> 5;
  f16v acc[2][4];
#pragma unroll
  for (int i = 0; i < 2; ++i)
#pragma unroll
    for (int j = 0; j < 4; ++j) acc[i][j] = zero16();
  const int lr = tid >> 2, lc = (tid & 3) * 8;
  const h16* Ap = A + (size_t)(row0 + lr) * lda + lc;
  const h16* Bp = Bt + (size_t)(col0 + lr) * ldb + lc;
  const size_t sa = (size_t)64 * lda, sb = (size_t)64 * ldb;
  uint4 ra0, ra1, rb0, rb1, rb2, rb3;
#define WLOAD(K0) ra0 = *(const uint4*)(Ap + (K0)); ra1 = *(const uint4*)(Ap + sa + (K0));                       \
  rb0 = *(const uint4*)(Bp + (K0)); rb1 = *(const uint4*)(Bp + sb + (K0));                                        \
  rb2 = *(const uint4*)(Bp + 2 * sb + (K0)); rb3 = *(const uint4*)(Bp + 3 * sb + (K0));
#define WWRITE(ST) { h16* as_ = As + (ST) * 15360 + lr * 40 + lc; h16* bs_ = Bs + (ST) * 15360 + lr * 40 + lc;   \
  *(uint4*)(as_) = ra0; *(uint4*)(as_ + 64 * 40) = ra1;                                                           \
  *(uint4*)(bs_) = rb0; *(uint4*)(bs_ + 64 * 40) = rb1; *(uint4*)(bs_ + 128 * 40) = rb2; *(uint4*)(bs_ + 192 * 40) = rb3; }
  WLOAD(0)
  WWRITE(0)
  __syncthreads();
  WLOAD(32)
#pragma unroll 1
  for (int k0 = 0; k0 < K; k0 += 32) {
    const int st = (k0 >> 5) & 1;
    if (k0 + 32 < K) {
      WWRITE(st ^ 1)
      if (k0 + 64 < K) { WLOAD(k0 + 64) }
    }
    const h16* Ac = As + st * 15360 + (wm * 64 + r) * 40 + hh * 8;
    const h16* Bc = Bs + st * 15360 + (wn * 128 + r) * 40 + hh * 8;
    __builtin_amdgcn_s_setprio(1);
#pragma unroll
    for (int kk = 0; kk < 2; ++kk) {
      const h8 a0 = *(const h8*)(Ac + kk * 16), a1 = *(const h8*)(Ac + 32 * 40 + kk * 16);
      const h8 b0 = *(const h8*)(Bc + kk * 16), b1 = *(const h8*)(Bc + 32 * 40 + kk * 16);
      const h8 b2 = *(const h8*)(Bc + 64 * 40 + kk * 16), b3 = *(const h8*)(Bc + 96 * 40 + kk * 16);
      acc[0][0] = MFMA(a0, b0, acc[0][0]); acc[0][1] = MFMA(a0, b1, acc[0][1]);
      acc[0][2] = MFMA(a0, b2, acc[0][2]); acc[0][3] = MFMA(a0, b3, acc[0][3]);
      acc[1][0] = MFMA(a1, b0, acc[1][0]); acc[1][1] = MFMA(a1, b1, acc[1][1]);
      acc[1][2] = MFMA(a1, b2, acc[1][2]); acc[1][3] = MFMA(a1, b3, acc[1][3]);
    }
    __builtin_amdgcn_s_setprio(0);
    __syncthreads();
  }
#undef WLOAD
#undef WWRITE
  if (!epi.has_tr(col0)) {
    char* sm = smem + wn * STG_T_OFF;
#pragma unroll
    for (int mi = 0; mi < 2; ++mi) {
      epi.frag(sm, row0 + wm * 64 + mi * 32, col0 + wn * 128, wm * 64 + mi * 32, 0, acc[mi][0], acc[mi][1]);
      epi.frag(sm, row0 + wm * 64 + mi * 32, col0 + wn * 128 + 64, wm * 64 + mi * 32, 64, acc[mi][2], acc[mi][3]);
    }
    __syncthreads();
    epi.copy(smem, row0, col0);
    epi.copy(smem + STG_T_OFF, row0, col0 + 128);
    __syncthreads();
    return;
  }
#pragma unroll
  for (int h = 0; h < 2; ++h) {
    if (wn == h) {
#pragma unroll
      for (int mi = 0; mi < 2; ++mi) {
        epi.frag(smem, row0 + wm * 64 + mi * 32, col0 + h * 128, wm * 64 + mi * 32, 0, acc[mi][0], acc[mi][1]);
        epi.frag(smem, row0 + wm * 64 + mi * 32, col0 + h * 128 + 64, wm * 64 + mi * 32, 64, acc[mi][2], acc[mi][3]);
      }
    }
    __syncthreads();
    epi.copy(smem, row0, col0 + h * 128);
    __syncthreads();
  }
}

DI void store_tr(h16* base, const f16v& cc, float bv, int hh) {
#pragma unroll
  for (int g = 0; g < 4; ++g) {
    h4 v;
#pragma unroll
    for (int e = 0; e < 4; ++e) v[e] = (h16)(cc[4 * g + e] + bv);
    *(h4*)(base + 16 * (g >> 1) + 8 * hh + 4 * (g & 1)) = v;
  }
}

DI int perm16pos(int t) { return (t & ~15) | ((t & 3) | ((t & 4) << 1) | ((t & 8) >> 1)); }
DI void stage_tr(h16* stT, int cl, int rlw, int hh, const f16v& cc, float bv) {
#pragma unroll
  for (int g = 0; g < 4; ++g) {
    h4 v;
#pragma unroll
    for (int e = 0; e < 4; ++e) v[e] = (h16)(cc[4 * g + e] + bv);
    *(h4*)(stT + cl * 136 + rlw + 16 * (g >> 1) + 8 * hh + 4 * (g & 1)) = v;
  }
}
template <class F>
DI void copy_tr(const h16* stT, int tid, F dstf) {
#pragma unroll 1
  for (int c = tid; c < 2048; c += 256) {
    const int cl = c >> 4, g8 = c & 15;
    h16* d = dstf(cl);
    if (d) *(uint4*)(d + g8 * 8) = *(const uint4*)(stT + cl * 136 + g8 * 8);
  }
}

struct EpiEven {
  const float* bias; const float* rda; const float* rml;
  h16 *QK4, *VT, *CQKV, *KR, *G;
  DI bool has_tr(int col0) const { return col0 + 256 > 1024 && col0 < 1536; }
  DI void frag(char* smem, int row0, int col0, int rlw, int clw, const f16v& c0, const f16v& c1) const {
    int tid_ = threadIdx.x; asm volatile("" : "+v"(tid_));
    const int lane = tid_ & 63, r = lane & 31, hh = lane >> 5;
    h16* stN = (h16*)smem;
    h16* stT = (h16*)(smem + STG_T_OFF);
    const int b = row0 / TB, jb = row0 - b * TB;
    const bool lat = jb < SEQ;
    if (col0 < 1024) {
      const int ca = col0 + r, cb2 = ca + 32;
      const float ba = bias[ca], bb = bias[cb2];
      const float qs = col0 < 512 ? 0.125f * LOG2E : 1.0f;
#pragma unroll
      for (int i = 0; i < 16; ++i) {
        const int rr = crow(i, hh);
        float v1 = c0[i] + ba, v2 = c1[i] + bb, o1 = v1, o2 = v2;
        if (lat) {
          const float2 cs = *(const float2*)(rda + ((size_t)(jb + rr) * 32 + r) * 2);
          o1 = v1 * cs.x - v2 * cs.y;
          o2 = v2 * cs.x + v1 * cs.y;
        }
        stN[(rlw + rr) * 136 + clw + r] = (h16)(o1 * qs);
        stN[(rlw + rr) * 136 + clw + 32 + r] = (h16)(o2 * qs);
        if ((i & 3) == 3) __builtin_amdgcn_sched_barrier(0);
      }
      return;
    }
#pragma unroll
    for (int half = 0; half < 2; ++half) {
      const int cb = col0 + 32 * half;
      if (cb >= EV_IN) continue;
      const f16v& cc = half ? c1 : c0;
      const int col = cb + r, cl = clw + 32 * half + r;
      const float bv = bias[col];
      if (cb < 1536) {
        stage_tr(stT, cl, rlw, hh, cc, bv);
      } else if (cb < 1920) {
#pragma unroll
        for (int i = 0; i < 16; ++i) stN[(rlw + crow(i, hh)) * 136 + cl] = (h16)(cc[i] + bv);
      } else if (cb == 1920) {
#pragma unroll
        for (int i = 0; i < 16; ++i) {
          const int rr = crow(i, hh);
          float v = cc[i] + bv;
          float pv = __shfl_xor(v, 16);
          float o = v;
          if (lat) {
            const float2 cs = *(const float2*)(rml + ((size_t)(jb + rr) * 16 + (r & 15)) * 2);
            o = (r < 16) ? (v * cs.x - pv * cs.y) : (v * cs.x + pv * cs.y);
          }
          stN[(rlw + rr) * 136 + cl] = (h16)o;
          __builtin_amdgcn_sched_barrier(0);
        }
      } else {
#pragma unroll
        for (int i = 0; i < 16; ++i) stN[(rlw + crow(i, hh)) * 136 + cl] = (h16)silu_f(cc[i] + bv);
      }
    }
  }
  DI void copy(char* smem, int row0, int col0) const {
    int tid = threadIdx.x; asm volatile("" : "+v"(tid));
    const h16* stN = (const h16*)smem;
    const h16* stT = (const h16*)(smem + STG_T_OFF);
    const int b = row0 / TB, jb = row0 - b * TB;
    if (col0 >= 1024 && col0 < 1536) {
      h16* base = VT + ((size_t)b * 512 + (col0 - 1024)) * TB + jb;
      copy_tr(stT, tid, [&](int cl) { return base + (size_t)cl * TB; });
      return;
    }
#pragma unroll 1
    for (int c = tid; c < 2048; c += 256) {
      const int rl = c >> 4, c8 = (c & 15) * 8, col = col0 + c8;
      const size_t row = (size_t)row0 + rl;
      h16* d;
      if (col < 1024) d = QK4 + row * 1024 + col;
      else if (col < 1920) d = CQKV + row * 384 + (col - 1536);
      else if (col < 1952) d = KR + row * 32 + (col - 1920);
      else if (col < EV_IN) d = G + row * 1024 + (col - 1952);
      else continue;
      *(uint4*)d = *(const uint4*)(stN + rl * 136 + c8);
    }
  }
};

struct EpiUQ {
  const float* rstd; int tile_row0; const float* rml; h16* QM;
  DI void frag(char* smem, int row0, int col0, int rlw, int clw, const f16v& c0, const f16v& c1) const {
    int tid_ = threadIdx.x; asm volatile("" : "+v"(tid_));
    const int lane = tid_ & 63, r = lane & 31, hh = lane >> 5;
    h16* stN = (h16*)smem;
    const int b = row0 / TB, jb = row0 - b * TB;
    const bool lat = jb < SEQ;
#pragma unroll
    for (int half = 0; half < 2; ++half) {
      const int cb = col0 + 32 * half;
      const f16v& cc = half ? c1 : c0;
      const bool rope = (cb % 96) == 64;
#pragma unroll
      for (int i = 0; i < 16; ++i) {
        const int rr = crow(i, hh);
        float v = cc[i] * rstd[rlw + rr];
        float pv = __shfl_xor(v, 16);
        float o = v;
        if (rope && lat) {
          const float2 cs = *(const float2*)(rml + ((size_t)(jb + rr) * 16 + (r & 15)) * 2);
          o = (r < 16) ? (v * cs.x - pv * cs.y) : (v * cs.x + pv * cs.y);
        }
        stN[(rlw + rr) * 136 + clw + 32 * half + r] = (h16)(o * (0.10206207261596575f * LOG2E));
        if ((i & 3) == 3) __builtin_amdgcn_sched_barrier(0);
      }
    }
  }
  DI void copy(char* smem, int row0, int col0) const {
    int tid = threadIdx.x; asm volatile("" : "+v"(tid));
    const h16* stN = (const h16*)smem;
#pragma unroll 1
    for (int c = tid; c < 2048; c += 256) {
      const int rl = c >> 4, c8 = (c & 15) * 8;
      *(uint4*)(QM + ((size_t)row0 + rl) * 768 + col0 + c8) = *(const uint4*)(stN + rl * 136 + c8);
    }
  }
};

struct EpiUKV {
  const float* rstd; int tile_row0; h16 *KN, *VMT;
  DI void frag(char* smem, int row0, int col0, int rlw, int clw, const f16v& c0, const f16v& c1) const {
    int tid_ = threadIdx.x; asm volatile("" : "+v"(tid_));
    const int lane = tid_ & 63, r = lane & 31, hh = lane >> 5;
    h16* stN = (h16*)smem;
    h16* stT = (h16*)(smem + STG_T_OFF);
    const bool isv = (col0 & 64) != 0;
#pragma unroll
    for (int half = 0; half < 2; ++half) {
      const f16v& cc = half ? c1 : c0;
      const int cl = clw + 32 * half + r;
      if (!isv) {
#pragma unroll
        for (int i = 0; i < 16; ++i) {
          const int rr = crow(i, hh);
          stN[(rlw + rr) * 136 + cl] = (h16)(cc[i] * rstd[rlw + rr]);
        }
      } else {
#pragma unroll
        for (int g = 0; g < 4; ++g) {
          h4 v;
#pragma unroll
          for (int e = 0; e < 4; ++e) v[e] = (h16)(cc[4 * g + e] * rstd[rlw + 8 * g + 4 * hh + e]);
          *(h4*)(stT + cl * 136 + rlw + 16 * (g >> 1) + 8 * hh + 4 * (g & 1)) = v;
        }
      }
    }
  }
  DI void copy(char* smem, int row0, int col0) const {
    int tid = threadIdx.x; asm volatile("" : "+v"(tid));
    const h16* stN = (const h16*)smem;
    const h16* stT = (const h16*)(smem + STG_T_OFF);
    const int b = row0 / TB, jb = row0 - b * TB;
    const int head = col0 >> 7;
#pragma unroll 1
    for (int c = tid; c < 1024; c += 256) {
      const int rl = c >> 3, c8 = (c & 7) * 8;
      *(uint4*)(KN + ((size_t)row0 + rl) * 512 + head * 64 + c8) = *(const uint4*)(stN + rl * 136 + c8);
    }
    h16* base = VMT + ((size_t)b * 512 + head * 64) * TB + jb;
    copy_tr(stT, tid, [&](int cl) -> h16* { return cl >= 64 ? base + (size_t)(cl - 64) * TB : (h16*)nullptr; });
  }
};

struct EpiOut {
  const float* xin; const float* cin; int layer; const float* mod; const h16* X16; h16* T;
  DI void frag(char* smem, int row0, int col0, int rlw, int clw, const f16v& c0, const f16v& c1) const {
    int tid_ = threadIdx.x; asm volatile("" : "+v"(tid_));
    const int lane = tid_ & 63, r = lane & 31, hh = lane >> 5;
    float* st = (float*)smem;
#pragma unroll
    for (int i = 0; i < 16; ++i) {
      st[(rlw + crow(i, hh)) * 132 + clw + r] = c0[i];
      st[(rlw + crow(i, hh)) * 132 + clw + 32 + r] = c1[i];
    }
  }
  DI void copy(char* smem, int row0, int col0) const {
    int tid = threadIdx.x; asm volatile("" : "+v"(tid));
    const float* st = (const float*)smem;
    const int b = row0 / TB, jb = row0 - b * TB;
    const int mr = jb < SEQ ? b : 4;
    const float* gp = mod + ((size_t)layer * 5 + mr) * 3072 + 2048;
#pragma unroll 1
    for (int c = tid; c < 4096; c += 256) {
      const int rl = c >> 5, c4 = (c & 31) * 4, col = col0 + c4;
      const size_t R = (size_t)row0 + rl;
      const float4 a = *(const float4*)(st + rl * 132 + c4);
      const float4 g = *(const float4*)(gp + col);
      float4 xv;
      if (layer == 0) {
        const int jj = jb + rl;
        const float* xp = jj < SEQ ? xin + ((size_t)b * SEQ + jj) * DM + col : cin + ((size_t)b * CTXL + (jj - SEQ)) * DM + col;
        xv = *(const float4*)xp;
      } else {
        const h4 xh = *(const h4*)(X16 + R * 1024 + col);
        xv.x = (float)xh[0]; xv.y = (float)xh[1]; xv.z = (float)xh[2]; xv.w = (float)xh[3];
      }
      float4 o;
      o.x = DN_ALPHA * xv.x + g.x * a.x; o.y = DN_ALPHA * xv.y + g.y * a.y;
      o.z = DN_ALPHA * xv.z + g.z * a.z; o.w = DN_ALPHA * xv.w + g.w * a.w;
      h4 oh; oh[0] = (h16)o.x; oh[1] = (h16)o.y; oh[2] = (h16)o.z; oh[3] = (h16)o.w;
      *(h4*)(T + R * 1024 + col) = oh;
    }
  }
};

struct EpiOdd {
  const float* bias; h16 *QKP, *MVT, *OG, *NAQ, *NAK, *NAVT, *G; float* GT;
  DI bool has_tr(int col0) const { return (col0 + 256 > 1024 && col0 < 1536) || (col0 + 256 > 3088 && col0 < 3600); }
  DI void frag(char* smem, int row0, int col0, int rlw, int clw, const f16v& c0, const f16v& c1) const {
    int tid_ = threadIdx.x; asm volatile("" : "+v"(tid_));
    const int lane = tid_ & 63, r = lane & 31, hh = lane >> 5;
    h16* stN = (h16*)smem;
    h16* stT = (h16*)(smem + STG_T_OFF);
#pragma unroll
    for (int half = 0; half < 2; ++half) {
      const f16v& cc = half ? c1 : c0;
      const int col = col0 + 32 * half + r, cl = clw + 32 * half + r;
      if (col >= OD_IN) continue;
      const float bv = bias[col];
      const bool tr = (col >= 1024 && col < 1536) || (col >= 3088 && col < 3600);
      if (tr) {
        stage_tr(stT, cl, rlw, hh, cc, bv);
      } else if (col >= 2048 && col < 2064) {
#pragma unroll
        for (int i = 0; i < 16; ++i) GT[(size_t)(row0 + crow(i, hh)) * 16 + (col - 2048)] = cc[i] + bv;
      } else if (col >= 1536 && col < 2048) {
#pragma unroll
        for (int i = 0; i < 16; ++i) stN[(rlw + crow(i, hh)) * 136 + cl] = (h16)sigmoid_f(cc[i] + bv);
      } else if (col >= 3600) {
#pragma unroll
        for (int i = 0; i < 16; ++i) stN[(rlw + crow(i, hh)) * 136 + cl] = (h16)silu_f(cc[i] + bv);
      } else {
#pragma unroll
        for (int i = 0; i < 16; ++i) stN[(rlw + crow(i, hh)) * 136 + cl] = (h16)(cc[i] + bv);
      }
    }
  }
  DI void copy(char* smem, int row0, int col0) const {
    int tid = threadIdx.x; asm volatile("" : "+v"(tid));
    const h16* stN = (const h16*)smem;
    const h16* stT = (const h16*)(smem + STG_T_OFF);
    const int b = row0 / TB, jb = row0 - b * TB;
#pragma unroll 1
    for (int c = tid; c < 2048; c += 256) {
      const int rl = c >> 4, c8 = (c & 15) * 8, col = col0 + c8;
      const size_t row = (size_t)row0 + rl;
      h16* d;
      if (col < 1024) d = QKP + row * 1024 + col;
      else if (col < 1536) continue;
      else if (col < 2048) d = OG + row * 512 + (col - 1536);
      else if (col < 2064) continue;
      else if (col < 2576) d = NAQ + row * 512 + (col - 2064);
      else if (col < 3088) d = NAK + row * 512 + (col - 2576);
      else if (col < 3600) continue;
      else if (col < OD_IN) d = G + row * 1024 + (col - 3600);
      else continue;
      *(uint4*)d = *(const uint4*)(stN + rl * 136 + c8);
    }
    if ((col0 + 128 > 1024 && col0 < 1536) || (col0 + 128 > 3088 && col0 < 3600)) {
      copy_tr(stT, tid, [&](int cl) -> h16* {
        const int col = col0 + cl;
        if (col >= 1024 && col < 1536) return MVT + ((size_t)b * 512 + (col - 1024)) * TB + jb;
        if (col >= 3088 && col < 3600) return NAVT + ((size_t)b * 512 + (col - 3088)) * TB + jb;
        return (h16*)nullptr;
      });
    }
  }
};

DI float softmax_tile(f16v& s, float& m, float& l, float sc, h8& p0, h8& p1) {
  float mx = s[0];
#pragma unroll
  for (int i = 1; i < 16; ++i) mx = fmaxf(mx, s[i]);
  mx = xhalf_max(mx) * sc;
  float mn = m, alpha = 1.0f;
  if (__any(mx > m + 8.0f)) {
    mn = fmaxf(m, mx);
    alpha = __builtin_amdgcn_exp2f(m - mn);
  }
  float sum = 0.f;
#pragma unroll
  for (int i = 0; i < 16; ++i) {
    float pv = __builtin_amdgcn_exp2f(s[i] * sc - mn);
    sum += pv;
    s[i] = pv;
  }
#pragma unroll
  for (int j = 0; j < 8; ++j) { p0[j] = (h16)s[j]; p1[j] = (h16)s[8 + j]; }
  l = l * alpha + sum;
  m = mn;
  return alpha;
}

DI float softmax_shifted(f16v& s, float& m, float& l, h8& qx, bool first, bool lo_half, h8& p0, h8& p1) {
  float sum = 0.f;
#pragma unroll
  for (int i = 0; i < 16; ++i) {
    const float pv = __builtin_amdgcn_exp2f(s[i]);
    sum += pv;
    s[i] = pv;
  }
  float alpha = 1.0f;
  if (__any(sum > 4096.0f) || first) {
    float mx = s[0];
#pragma unroll
    for (int i = 1; i < 16; ++i) mx = fmaxf(mx, s[i]);
    mx = fmaxf(xhalf_max(mx), 1e-30f);
    float d = __builtin_amdgcn_logf(mx);
    if (!first) d = fmaxf(d, 0.f);
    const float mn = (float)(h16)(m + d);
    d = mn - m;
    const float f = __builtin_amdgcn_exp2f(-d);
#pragma unroll
    for (int i = 0; i < 16; ++i) s[i] *= f;
    sum *= f;
    alpha = first ? 1.0f : f;
    m = mn;
    qx[0] = lo_half ? (h16)(-mn) : (h16)0.f;
  }
#pragma unroll
  for (int j = 0; j < 8; ++j) { p0[j] = (h16)s[j]; p1[j] = (h16)s[8 + j]; }
  l = l * alpha + sum;
  return alpha;
}

template <int NMAP, int NKK, int NDVT, class KL, class VL>
DI void flash_wave(const h8 (&qf)[NMAP][NKK], f16v (&O)[NMAP][NDVT], float (&mm)[NMAP], float (&ll)[NMAP], int t0, int t1,
                   float sc, KL kl, VL vl) {
  for (int t = t0; t < t1; ++t) {
    f16v S[NMAP];
    h8 pf[NMAP][2];
    float al[NMAP];
#pragma unroll
    for (int m = 0; m < NMAP; ++m) {
      S[m] = zero16();
#pragma unroll
      for (int kk = 0; kk < NKK; ++kk) S[m] = MFMA(kl(m, kk, t), qf[m][kk], S[m]);
    }
#pragma unroll
    for (int m = 0; m < NMAP; ++m) al[m] = softmax_tile(S[m], mm[m], ll[m], sc, pf[m][0], pf[m][1]);
#pragma unroll
    for (int m = 0; m < NMAP; ++m)
#pragma unroll
      for (int d = 0; d < NDVT; ++d)
#pragma unroll
        for (int i = 0; i < 16; ++i) O[m][d][i] *= al[m];
#pragma unroll
    for (int d = 0; d < NDVT; ++d)
#pragma unroll
      for (int s = 0; s < 2; ++s) {
        h8 vf = vl(d, t, s);
#pragma unroll
        for (int m = 0; m < NMAP; ++m) O[m][d] = MFMA(vf, pf[m][s], O[m][d]);
      }
  }
}

template <int OFF> DI void lds_rd(h8& d, unsigned a) { asm volatile("ds_read_b128 %0, %1 offset:%2" : "=v"(d) : "v"(a), "n"(OFF)); }
#define LGKM_WAIT4(N, a, b, c, d) asm volatile("s_waitcnt lgkmcnt(" #N ")" : "+v"(a), "+v"(b), "+v"(c), "+v"(d))
#define LGKM_WAIT6(N, a, b, c, d, e, f) asm volatile("s_waitcnt lgkmcnt(" #N ")" : "+v"(a), "+v"(b), "+v"(c), "+v"(d), "+v"(e), "+v"(f))
#define LGKM_WAIT8(N, a, b, c, d, e, f, g, h) asm volatile("s_waitcnt lgkmcnt(" #N ")" : "+v"(a), "+v"(b), "+v"(c), "+v"(d), "+v"(e), "+v"(f), "+v"(g), "+v"(h))
#define LGKM_WAIT5(N, a, b, c, d, e) asm volatile("s_waitcnt lgkmcnt(" #N ")" : "+v"(a), "+v"(b), "+v"(c), "+v"(d), "+v"(e))
#define LGKM_WAIT9(N, a, b, c, d, e, f, g, h, i) asm volatile("s_waitcnt lgkmcnt(" #N ")" : "+v"(a), "+v"(b), "+v"(c), "+v"(d), "+v"(e), "+v"(f), "+v"(g), "+v"(h), "+v"(i))

template <int mp>
DI void da_map(const Params& p, int layer, int b, int hd, int qj0, int t0, int t1, float lam, float lam_init, char* smem, int dry) {
  char* ws = p.ws; asm volatile("" : "+s"(ws));
  const h16* QK4 = (const h16*)(ws + OFF_QK4);
  const h16* VT = (const h16*)(ws + OFF_VT);
  h16* AM = (h16*)(ws + OFF_H);
  h16* GY = (h16*)(ws + OFF_GY);
  int tid = threadIdx.x; asm volatile("" : "+v"(tid));
  const int lane = tid & 63, w = tid >> 6, r = lane & 31, hh = lane >> 5;
  const size_t R = (size_t)b * TB + qj0 + w * 32 + r;
  h16* Ks = (h16*)smem;
  h16* Vs = (h16*)(smem + 2 * 9216);
  {
  h8 qf[4];
#pragma unroll
  for (int kk = 0; kk < 4; ++kk) qf[kk] = *(const h8*)(QK4 + R * 1024 + mp * 256 + hd * 64 + kk * 16 + hh * 8);
  const float sc = 0.125f * LOG2E;
  const h16* kg = QK4 + ((size_t)b * TB + (tid >> 3)) * 1024 + 512 + mp * 256 + hd * 64 + (tid & 7) * 8;
  const int kd = (tid >> 3) * 72 + (tid & 7) * 8;
  const h16* vg = VT + ((size_t)b * 512 + hd * 128 + (tid >> 3)) * TB + (tid & 7) * 8;
  const int vd = (tid >> 3) * 72 + (tid & 7) * 8;
  uint4 k0, k1, v0, v1, v2, v3;
#define KLOAD(T) { const h16* s_ = kg + (size_t)(T) * 65536; k0 = *(const uint4*)s_; k1 = *(const uint4*)(s_ + 32768); }
#define KWRITE(ST) { h16* d_ = Ks + (ST) * 4608 + kd; *(uint4*)d_ = k0; *(uint4*)(d_ + 32 * 72) = k1; }
#define VLOAD(T) { const h16* s_ = vg + (T) * 64; v0 = *(const uint4*)s_; v1 = *(const uint4*)(s_ + (size_t)32 * TB); v2 = *(const uint4*)(s_ + (size_t)64 * TB); v3 = *(const uint4*)(s_ + (size_t)96 * TB); }
#define VWRITE(ST) { h16* d_ = Vs + (ST) * 9216 + vd; *(uint4*)d_ = v0; *(uint4*)(d_ + 32 * 72) = v1; *(uint4*)(d_ + 64 * 72) = v2; *(uint4*)(d_ + 96 * 72) = v3; }
  f16v O0 = zero16(), O1 = zero16(), O2 = zero16(), O3 = zero16();
  float m = 0.f, l = 0.f;
  h8 kx, qx;
#pragma unroll
  for (int j = 0; j < 8; ++j) { kx[j] = (h16)0.f; qx[j] = (h16)0.f; }
  kx[0] = hh == 0 ? (h16)1.f : (h16)0.f;
  KLOAD(t0) VLOAD(t0) KWRITE(0) VWRITE(0)
  __syncthreads();
#pragma unroll 1
  for (int t = t0; t < t1; ++t) {
    const int st = (t - t0) & 1;
    const bool more = t + 1 < t1;
    if (more) { KLOAD(t + 1) VLOAD(t + 1) }
    const unsigned ka = (unsigned)(size_t)(Ks + st * 4608 + r * 72 + hh * 8);
    const unsigned va = (unsigned)(size_t)(Vs + st * 9216 + r * 72 + hh * 8);
    h8 a0, a1, a2, a3, b0, b1, b2, b3, g0, g1, g2, g3, g4, g5, g6, g7;
    lds_rd<0>(a0, ka); lds_rd<32>(a1, ka); lds_rd<64>(a2, ka); lds_rd<96>(a3, ka);
    lds_rd<4608 + 0>(b0, ka); lds_rd<4608 + 32>(b1, ka); lds_rd<4608 + 64>(b2, ka); lds_rd<4608 + 96>(b3, ka);
    lds_rd<0>(g0, va); lds_rd<32>(g1, va); lds_rd<4608>(g2, va); lds_rd<4608 + 32>(g3, va);
    lds_rd<9216>(g4, va); lds_rd<9216 + 32>(g5, va); lds_rd<13824>(g6, va); lds_rd<13824 + 32>(g7, va);
    f16v Sa = MFMA(kx, qx, zero16()), Sb = Sa;
    LGKM_WAIT4(12, a0, a1, a2, a3);
    Sa = MFMA(a0, qf[0], Sa); Sa = MFMA(a1, qf[1], Sa); Sa = MFMA(a2, qf[2], Sa); Sa = MFMA(a3, qf[3], Sa);
    LGKM_WAIT4(8, b0, b1, b2, b3);
    Sb = MFMA(b0, qf[0], Sb); Sb = MFMA(b1, qf[1], Sb); Sb = MFMA(b2, qf[2], Sb); Sb = MFMA(b3, qf[3], Sb);
    const float mprev = m;
    {
      h8 p0, p1;
      const float al = softmax_shifted(Sa, m, l, qx, t == t0, hh == 0, p0, p1);
      if (__any(al != 1.0f)) {
#pragma unroll
        for (int i = 0; i < 16; ++i) { O0[i] *= al; O1[i] *= al; O2[i] *= al; O3[i] *= al; }
      }
      LGKM_WAIT9(0, g0, g1, g2, g3, g4, g5, g6, g7, p0);
      O0 = MFMA(g0, p0, O0); O1 = MFMA(g2, p0, O1); O2 = MFMA(g4, p0, O2); O3 = MFMA(g6, p0, O3);
      O0 = MFMA(g1, p1, O0); O1 = MFMA(g3, p1, O1); O2 = MFMA(g5, p1, O2); O3 = MFMA(g7, p1, O3);
    }
    lds_rd<64>(g0, va); lds_rd<96>(g1, va); lds_rd<4608 + 64>(g2, va); lds_rd<4608 + 96>(g3, va);
    lds_rd<9216 + 64>(g4, va); lds_rd<9216 + 96>(g5, va); lds_rd<13824 + 64>(g6, va); lds_rd<13824 + 96>(g7, va);
    {
      h8 p0, p1;
      if (m != mprev) {
        const float d = m - mprev;
#pragma unroll
        for (int i = 0; i < 16; ++i) Sb[i] -= d;
      }
      const float al = softmax_shifted(Sb, m, l, qx, false, hh == 0, p0, p1);
      if (__any(al != 1.0f)) {
#pragma unroll
        for (int i = 0; i < 16; ++i) { O0[i] *= al; O1[i] *= al; O2[i] *= al; O3[i] *= al; }
      }
      LGKM_WAIT9(0, g0, g1, g2, g3, g4, g5, g6, g7, p0);
      O0 = MFMA(g0, p0, O0); O1 = MFMA(g2, p0, O1); O2 = MFMA(g4, p0, O2); O3 = MFMA(g6, p0, O3);
      O0 = MFMA(g1, p1, O0); O1 = MFMA(g3, p1, O1); O2 = MFMA(g5, p1, O2); O3 = MFMA(g7, p1, O3);
    }
    if (more) { KWRITE(st ^ 1) VWRITE(st ^ 1) }
    __syncthreads();
  }
#undef KLOAD
#undef KWRITE
#undef VLOAD
#undef VWRITE
  size_t Rm = R; asm volatile("" : "+v"(Rm));
  int hdm = hd; asm volatile("" : "+s"(hdm));
  const float il = 1.f / xhalf_sum(l);
  if (mp == 0) {
#pragma unroll
    for (int d = 0; d < 4; ++d)
#pragma unroll
      for (int g = 0; g < 4; ++g) {
        const int dv = d * 32 + 8 * g + 4 * hh;
        h4 ov;
#pragma unroll
        for (int e = 0; e < 4; ++e) {
          const float o = d == 0 ? O0[4 * g + e] : d == 1 ? O1[4 * g + e] : d == 2 ? O2[4 * g + e] : O3[4 * g + e];
          ov[e] = (h16)(o * il);
        }
        *(h4*)(AM + Rm * 512 + hdm * 128 + dv) = ov;
      }
  } else {
    const float f = lam * il;
    float ss = 0.f;
#pragma unroll
    for (int d = 0; d < 4; ++d)
#pragma unroll
      for (int g = 0; g < 4; ++g) {
        const int dv = d * 32 + 8 * g + 4 * hh;
        const h4 a1 = *(const h4*)(AM + Rm * 512 + hdm * 128 + dv);
#pragma unroll
        for (int e = 0; e < 4; ++e) {
          const float oo = d == 0 ? O0[4 * g + e] : d == 1 ? O1[4 * g + e] : d == 2 ? O2[4 * g + e] : O3[4 * g + e];
          const float o = (float)a1[e] - f * oo;
          if (d == 0) O0[4 * g + e] = o; else if (d == 1) O1[4 * g + e] = o; else if (d == 2) O2[4 * g + e] = o; else O3[4 * g + e] = o;
          ss += o * o;
        }
      }
    ss += __shfl_xor(ss, 32);
    const float rs = rsqrtf(ss * (1.f / 128.f) + 1e-6f) * (1.f - lam_init);
    const float* sg = p.da_subln_g + (layer >> 1) * 128;
    if (!dry) {
#pragma unroll
      for (int d = 0; d < 4; ++d)
#pragma unroll
        for (int g = 0; g < 4; ++g) {
          const int dv = d * 32 + 8 * g + 4 * hh;
          h16* yp = GY + Rm * 1024 + hdm * 128 + dv;
          h4 gv = *(const h4*)yp, ov;
#pragma unroll
          for (int e = 0; e < 4; ++e) {
            const float o = d == 0 ? O0[4 * g + e] : d == 1 ? O1[4 * g + e] : d == 2 ? O2[4 * g + e] : O3[4 * g + e];
            ov[e] = (h16)(o * rs * sg[dv + e] * (float)gv[e]);
          }
          *(h4*)yp = ov;
        }
    }
  }
  }
}

DI void da_item(const Params& p, int layer, int b, int hd, int qj0, int t0, int t1, float lam, float lam_init, char* smem, int dry) {
  da_map<0>(p, layer, b, hd, qj0, t0, t1, lam, lam_init, smem, dry);
  da_map<1>(p, layer, b, hd, qj0, t0, t1, lam, lam_init, smem, dry);
}

DI void mla_item(const Params& p, int b, int hd, int qj0, int t0, int t1, char* smem, int dry) {
  char* ws = p.ws; asm volatile("" : "+s"(ws));
  const h16* QM = (const h16*)(ws + OFF_QM);
  const h16* KN = (const h16*)(ws + OFF_KN);
  const h16* KR = (const h16*)(ws + OFF_KR);
  const h16* VMT = (const h16*)(ws + OFF_VMT);
  h16* GY = (h16*)(ws + OFF_GY);
  int tid = threadIdx.x; asm volatile("" : "+v"(tid));
  const int lane = tid & 63, w = tid >> 6, r = lane & 31, hh = lane >> 5;
  const size_t R = (size_t)b * TB + qj0 + w * 64 + r;
  h16* Ks = (h16*)smem;
  h16* Vs = (h16*)(smem + 2 * 13312);
  h8 qa[6], qb[6];
#pragma unroll
  for (int kk = 0; kk < 6; ++kk) {
    qa[kk] = *(const h8*)(QM + R * 768 + hd * 96 + kk * 16 + hh * 8);
    qb[kk] = *(const h8*)(QM + (R + 32) * 768 + hd * 96 + kk * 16 + hh * 8);
  }
  const float sc = 0.10206207261596575f * LOG2E;
  const h16* kng = KN + ((size_t)b * TB + (tid >> 3)) * 512 + hd * 64 + (tid & 7) * 8;
  const int knd = (tid >> 3) * 104 + (tid & 7) * 8;
  const h16* krg = KR + ((size_t)b * TB + (tid >> 2)) * 32 + (tid & 3) * 8;
  const int krd = (tid >> 2) * 104 + 64 + (tid & 3) * 8;
  const h16* vg = VMT + ((size_t)b * 512 + hd * 64 + (tid >> 3)) * TB + (tid & 7) * 8;
  const int vd = (tid >> 3) * 72 + (tid & 7) * 8;
  uint4 k0, k1, k2, v0, v1;
#define MLOAD(T) { const h16* s_ = kng + (size_t)(T) * 32768; k0 = *(const uint4*)s_; k1 = *(const uint4*)(s_ + 16384); k2 = *(const uint4*)(krg + (size_t)(T) * 2048); \
                   const h16* u_ = vg + (T) * 64; v0 = *(const uint4*)u_; v1 = *(const uint4*)(u_ + (size_t)32 * TB); }
#define MWRITE(ST) { h16* d_ = Ks + (ST) * 6656; *(uint4*)(d_ + knd) = k0; *(uint4*)(d_ + knd + 32 * 104) = k1; *(uint4*)(d_ + krd) = k2; \
                     h16* e_ = Vs + (ST) * 4608 + vd; *(uint4*)e_ = v0; *(uint4*)(e_ + 32 * 72) = v1; }
  f16v Oa0 = zero16(), Oa1 = zero16(), Ob0 = zero16(), Ob1 = zero16();
  float ma = 0.f, la = 0.f, mb = 0.f, lb = 0.f;
  h8 kx, qxa, qxb;
#pragma unroll
  for (int j = 0; j < 8; ++j) { kx[j] = (h16)0.f; qxa[j] = (h16)0.f; qxb[j] = (h16)0.f; }
  kx[0] = hh == 0 ? (h16)1.f : (h16)0.f;
  MLOAD(t0) MWRITE(0)
  __syncthreads();
#pragma unroll 1
  for (int t = t0; t < t1; ++t) {
    const int st = (t - t0) & 1;
    const bool more = t + 1 < t1;
    const unsigned ka = (unsigned)(size_t)(Ks + st * 6656 + r * 104 + hh * 8);
    const unsigned va = (unsigned)(size_t)(Vs + st * 4608 + r * 72 + hh * 8);
#pragma unroll 2
    for (int sub = 0; sub < 2; ++sub) {
      if (sub == 1 && more) MLOAD(t + 1)
      const unsigned kas = ka + sub * 6656, vas = va + sub * 64;
      h8 f0, f1, f2, f3, f4, f5, g0, g1, g2, g3;
      lds_rd<0>(f0, kas); lds_rd<32>(f1, kas); lds_rd<64>(f2, kas); lds_rd<96>(f3, kas); lds_rd<128>(f4, kas); lds_rd<160>(f5, kas);
      f16v Sa = MFMA(kx, qxa, zero16()), Sb = MFMA(kx, qxb, zero16());
      LGKM_WAIT6(0, f0, f1, f2, f3, f4, f5);
      Sa = MFMA(f0, qa[0], Sa); Sb = MFMA(f0, qb[0], Sb);
      Sa = MFMA(f1, qa[1], Sa); Sb = MFMA(f1, qb[1], Sb);
      Sa = MFMA(f2, qa[2], Sa); Sb = MFMA(f2, qb[2], Sb);
      Sa = MFMA(f3, qa[3], Sa); Sb = MFMA(f3, qb[3], Sb);
      Sa = MFMA(f4, qa[4], Sa); Sb = MFMA(f4, qb[4], Sb);
      Sa = MFMA(f5, qa[5], Sa); Sb = MFMA(f5, qb[5], Sb);
      h8 pa0, pa1, pb0, pb1;
      const bool first = (t == t0) && (sub == 0);
      const float ala = softmax_shifted(Sa, ma, la, qxa, first, hh == 0, pa0, pa1);
      if (__any(ala != 1.0f)) {
#pragma unroll
        for (int i = 0; i < 16; ++i) { Oa0[i] *= ala; Oa1[i] *= ala; }
      }
      lds_rd<0>(g0, vas); lds_rd<32>(g1, vas); lds_rd<4608>(g2, vas); lds_rd<4608 + 32>(g3, vas);
      const float alb = softmax_shifted(Sb, mb, lb, qxb, first, hh == 0, pb0, pb1);
      if (__any(alb != 1.0f)) {
#pragma unroll
        for (int i = 0; i < 16; ++i) { Ob0[i] *= alb; Ob1[i] *= alb; }
      }
      LGKM_WAIT6(0, g0, g1, g2, g3, pa0, pb0);
      Oa0 = MFMA(g0, pa0, Oa0); Ob0 = MFMA(g0, pb0, Ob0);
      Oa1 = MFMA(g2, pa0, Oa1); Ob1 = MFMA(g2, pb0, Ob1);
      Oa0 = MFMA(g1, pa1, Oa0); Ob0 = MFMA(g1, pb1, Ob0);
      Oa1 = MFMA(g3, pa1, Oa1); Ob1 = MFMA(g3, pb1, Ob1);
    }
    if (more) MWRITE(st ^ 1)
    __syncthreads();
  }
#undef MLOAD
#undef MWRITE
  const float ia = 1.f / xhalf_sum(la), ib = 1.f / xhalf_sum(lb);
  if (!dry) {
#pragma unroll
    for (int d = 0; d < 2; ++d)
#pragma unroll
      for (int g = 0; g < 4; ++g) {
        const int dv = d * 32 + 8 * g + 4 * hh;
        {
          h16* yp = GY + R * 1024 + 512 + hd * 64 + dv;
          h4 gv = *(const h4*)yp, ov;
#pragma unroll
          for (int e = 0; e < 4; ++e) ov[e] = (h16)((d ? Oa1[4 * g + e] : Oa0[4 * g + e]) * ia * (float)gv[e]);
          *(h4*)yp = ov;
        }
        {
          h16* yp = GY + (R + 32) * 1024 + 512 + hd * 64 + dv;
          h4 gv = *(const h4*)yp, ov;
#pragma unroll
          for (int e = 0; e < 4; ++e) ov[e] = (h16)((d ? Ob1[4 * g + e] : Ob0[4 * g + e]) * ib * (float)gv[e]);
          *(h4*)yp = ov;
        }
      }
  }
}

DI void na_wave(const Params& p, int layer, int b, int gr, int hp, char* smem, int dry) {
  char* ws = p.ws; asm volatile("" : "+s"(ws));
  const h16* NAQ = (const h16*)(ws + OFF_NAQ);
  const h16* NAK = (const h16*)(ws + OFF_NAK);
  const h16* NAVT = (const h16*)(ws + OFF_NAVT);
  h16* GY = (h16*)(ws + OFF_GY);
  int tid_ = threadIdx.x; asm volatile("" : "+v"(tid_));
  const int lane = tid_ & 63, w = tid_ >> 6, r = lane & 31, hh = lane >> 5;
  const int hd = hp * 2 + (w >> 1), half = w & 1;
  float* tbl = (float*)smem;
  __syncthreads();
  for (int i = tid_; i < 2 * 465; i += 256) {
    const int hs = i >= 465, j = i - hs * 465;
    tbl[hs * 480 + j] = p.na_rpb[((size_t)(layer >> 1) * 8 + hp * 2 + hs) * 465 + j];
  }
  __syncthreads();
  const float* rpb = tbl + (w >> 1) * 480;
  const int c = half * 32 + r;
  const int cs = min(max(c - 8, 0), 48);
  const int rs = min(max(gr - 4, 0), 120);
  const size_t R = (size_t)b * TB + gr * 64 + c;
  h8 qf[4];
#pragma unroll
  for (int kk = 0; kk < 4; ++kk) qf[kk] = *(const h8*)(NAQ + R * 512 + hd * 64 + kk * 16 + hh * 8);
  f16v O0 = zero16(), O1 = zero16();
  float m = -1e30f, l = 0.f;
  const float sc = 0.125f * LOG2E;
  const h16* kbase = NAK + ((size_t)b * TB + r) * 512 + hd * 64 + hh * 8;
  const h16* vbase = NAVT + ((size_t)b * 512 + hd * 64 + r) * TB + 8 * hh;
  auto tile_j0 = [&](int t) { return t < 16 ? (rs + (t >> 1)) * 64 + (t & 1) * 32 : SEQ + (t - 16) * 32; };
  struct Fr { h8 k0, k1, k2, k3, v00, v01, v10, v11; };
  auto load = [&](int t) {
    const int j0 = tile_j0(t);
    const h16* kp = kbase + (size_t)j0 * 512;
    const h16* vb = vbase + j0;
    Fr f;
    f.k0 = *(const h8*)(kp); f.k1 = *(const h8*)(kp + 16); f.k2 = *(const h8*)(kp + 32); f.k3 = *(const h8*)(kp + 48);
    f.v00 = *(const h8*)(vb); f.v01 = *(const h8*)(vb + 16);
    f.v10 = *(const h8*)(vb + (size_t)32 * TB); f.v11 = *(const h8*)(vb + (size_t)32 * TB + 16);
    return f;
  };
  auto compute = [&](const Fr& f, int t) {
    f16v S = zero16();
    S = MFMA(f.k0, qf[0], S); S = MFMA(f.k1, qf[1], S); S = MFMA(f.k2, qf[2], S); S = MFMA(f.k3, qf[3], S);
    float mx = -1e30f;
    if (t < 16) {
      const int krow_g = rs + (t >> 1), kc0 = (t & 1) * 32;
      const float* bp = rpb + (krow_g - gr + 7) * 31 + (15 - c);
#pragma unroll
      for (int i = 0; i < 16; ++i) {
        const int kj = kc0 + crow(i, hh);
        const bool valid = (kj >= cs) && (kj < cs + 16);
        float v = -1e30f;
        if (valid) v = (S[i] * 0.125f + bp[kj]) * LOG2E;
        S[i] = v;
        mx = fmaxf(mx, v);
      }
    } else {
#pragma unroll
      for (int i = 0; i < 16; ++i) { S[i] *= sc; mx = fmaxf(mx, S[i]); }
    }
    mx = xhalf_max(mx);
    const float mn = fmaxf(m, mx);
    const float alpha = __builtin_amdgcn_exp2f(m - mn);
    float sum = 0.f;
#pragma unroll
    for (int i = 0; i < 16; ++i) {
      float pv = (S[i] > -1e29f) ? __builtin_amdgcn_exp2f(S[i] - mn) : 0.f;
      sum += pv;
      S[i] = pv;
    }
    l = l * alpha + sum;
    m = mn;
    h8 p0, p1;
#pragma unroll
    for (int j = 0; j < 8; ++j) { p0[j] = (h16)S[j]; p1[j] = (h16)S[8 + j]; }
    if (__any(alpha != 1.0f)) {
#pragma unroll
      for (int i = 0; i < 16; ++i) { O0[i] *= alpha; O1[i] *= alpha; }
    }
    O0 = MFMA(f.v00, p0, O0); O0 = MFMA(f.v01, p1, O0);
    O1 = MFMA(f.v10, p0, O1); O1 = MFMA(f.v11, p1, O1);
  };
  Fr fa = load(0);
#pragma unroll 1
  for (int t = 0; t < 24; t += 2) {
    Fr fb = load(t + 1);
    __builtin_amdgcn_sched_barrier(0);
    compute(fa, t);
    __builtin_amdgcn_sched_barrier(0);
    if (t + 2 < 24) fa = load(t + 2);
    __builtin_amdgcn_sched_barrier(0);
    compute(fb, t + 1);
    __builtin_amdgcn_sched_barrier(0);
  }
  l += __shfl_xor(l, 32);
  const float il = 1.f / l;
  if (!dry)
#pragma unroll
  for (int d = 0; d < 2; ++d)
#pragma unroll
    for (int g = 0; g < 4; ++g) {
      const int dv = d * 32 + 8 * g + 4 * hh;
      h16* yp = GY + R * 1024 + 512 + hd * 64 + dv;
      h4 gv = *(const h4*)yp, ov;
#pragma unroll
      for (int e = 0; e < 4; ++e) ov[e] = (h16)((d ? O1[4 * g + e] : O0[4 * g + e]) * il * (float)gv[e]);
      *(h4*)yp = ov;
    }
}

DI void nactx_item(const Params& p, int b, int hd, int qt, int dry) {
  char* ws = p.ws; asm volatile("" : "+s"(ws));
  const h16* NAQ = (const h16*)(ws + OFF_NAQ);
  const h16* NAK = (const h16*)(ws + OFF_NAK);
  const h16* NAVT = (const h16*)(ws + OFF_NAVT);
  h16* GY = (h16*)(ws + OFF_GY);
  int tid_ = threadIdx.x; asm volatile("" : "+v"(tid_));
  const int lane = tid_ & 63, w = tid_ >> 6, r = lane & 31, hh = lane >> 5;
  const size_t R = (size_t)b * TB + SEQ + qt * 128 + w * 32 + r;
  h8 qf[1][4];
#pragma unroll
  for (int kk = 0; kk < 4; ++kk) qf[0][kk] = *(const h8*)(NAQ + R * 512 + hd * 64 + kk * 16 + hh * 8);
  f16v O[1][2];
  O[0][0] = zero16(); O[0][1] = zero16();
  float mm[1] = {-1e30f}, ll[1] = {0.f};
  const h16* kb = NAK + ((size_t)b * TB + r) * 512 + hd * 64 + hh * 8;
  const h16* vbase = NAVT + ((size_t)b * 512 + hd * 64 + r) * TB + 8 * hh;
  flash_wave<1, 4, 2>(qf, O, mm, ll, 256, 264, 0.125f * LOG2E,
      [&](int m, int kk, int t) { return *(const h8*)(kb + (size_t)t * 32 * 512 + kk * 16); },
      [&](int d, int t, int s) { return *(const h8*)(vbase + (size_t)d * 32 * TB + t * 32 + 16 * s); });
  const float l1 = ll[0] + __shfl_xor(ll[0], 32);
  const float i1 = 1.f / l1;
  if (!dry)
#pragma unroll
  for (int d = 0; d < 2; ++d)
#pragma unroll
    for (int g = 0; g < 4; ++g) {
      const int dv = d * 32 + 8 * g + 4 * hh;
      h16* yp = GY + R * 1024 + 512 + hd * 64 + dv;
      h4 gv = *(const h4*)yp, ov;
#pragma unroll
      for (int e = 0; e < 4; ++e) ov[e] = (h16)(O[0][d][4 * g + e] * i1 * (float)gv[e]);
      *(h4*)yp = ov;
    }
}

DI int chunk_j0(int dir, int k) {
  if (k < 2) return SEQ + (dir ? 1 - k : k) * 128;
  return (dir ? 63 - (k - 2) : (k - 2)) * 128;
}
DI int tokchunk_k(int dir, int kc) {
  if (kc >= 64) { int cc = kc - 64; return dir ? 1 - cc : cc; }
  return 2 + (dir ? 63 - kc : kc);
}

DI void scan_sum2(float v0, float v1, int lane, float& o0, float& o1) {
  float s = v0 + v1;
#pragma unroll
  for (int off = 1; off < 64; off <<= 1) { float t = __shfl_up(s, off); if (lane >= off) s += t; }
  o1 = s; o0 = s - v1;
}
DI void scan_max2(float v0, float v1, int lane, float& o0, float& o1) {
  float s = fmaxf(v0, v1);
#pragma unroll
  for (int off = 1; off < 64; off <<= 1) { float t = __shfl_up(s, off); if (lane >= off) s = fmaxf(s, t); }
  float ex = __shfl_up(s, 1);
  if (lane == 0) ex = -1e30f;
  o1 = s; o0 = fmaxf(ex, v0);
}

DI void conv8(const h16* __restrict__ QKP, size_t rowbase, int pidx, int col, bool has_prev, bool has_next,
              const float* __restrict__ cw, const float* __restrict__ cb, float (&y)[8]) {
  {
    const float4 b0 = *(const float4*)(cb + col), b1 = *(const float4*)(cb + col + 4);
    y[0] = b0.x; y[1] = b0.y; y[2] = b0.z; y[3] = b0.w; y[4] = b1.x; y[5] = b1.y; y[6] = b1.z; y[7] = b1.w;
  }
#pragma unroll
  for (int t = 0; t < 5; ++t) {
    const int pp = pidx + t - 2;
    const bool ok = (pp >= 0 || has_prev) && (pp < 128 || has_next);
    if (ok) {
      const h8 xv = *(const h8*)(QKP + (size_t)((long)rowbase + pp) * 1024 + col);
      const float4 w0 = *(const float4*)(cw + t * 1024 + col), w1 = *(const float4*)(cw + t * 1024 + col + 4);
      y[0] += (float)xv[0] * w0.x; y[1] += (float)xv[1] * w0.y; y[2] += (float)xv[2] * w0.z; y[3] += (float)xv[3] * w0.w;
      y[4] += (float)xv[4] * w1.x; y[5] += (float)xv[5] * w1.y; y[6] += (float)xv[6] * w1.z; y[7] += (float)xv[7] * w1.w;
    }
  }
#pragma unroll
  for (int e = 0; e < 8; ++e) y[e] = silu_f(y[e]);
}

struct ConvW { float4 w[5][2]; float4 b[2]; };
DI ConvW load_convw(const float* __restrict__ cw, const float* __restrict__ cb, int col) {
  ConvW c;
#pragma unroll
  for (int t = 0; t < 5; ++t) { c.w[t][0] = *(const float4*)(cw + t * 1024 + col); c.w[t][1] = *(const float4*)(cw + t * 1024 + col + 4); }
  c.b[0] = *(const float4*)(cb + col); c.b[1] = *(const float4*)(cb + col + 4);
  return c;
}
DI void conv8w(const h16* __restrict__ QKP, size_t rowbase, int pidx, int col, bool has_prev, bool has_next, const ConvW& c, float (&y)[8]) {
  y[0] = c.b[0].x; y[1] = c.b[0].y; y[2] = c.b[0].z; y[3] = c.b[0].w; y[4] = c.b[1].x; y[5] = c.b[1].y; y[6] = c.b[1].z; y[7] = c.b[1].w;
#pragma unroll
  for (int t = 0; t < 5; ++t) {
    const int pp = pidx + t - 2;
    const bool ok = (pp >= 0 || has_prev) && (pp < 128 || has_next);
    if (ok) {
      const h8 xv = *(const h8*)(QKP + (size_t)((long)rowbase + pp) * 1024 + col);
      y[0] += (float)xv[0] * c.w[t][0].x; y[1] += (float)xv[1] * c.w[t][0].y; y[2] += (float)xv[2] * c.w[t][0].z; y[3] += (float)xv[3] * c.w[t][0].w;
      y[4] += (float)xv[4] * c.w[t][1].x; y[5] += (float)xv[5] * c.w[t][1].y; y[6] += (float)xv[6] * c.w[t][1].z; y[7] += (float)xv[7] * c.w[t][1].w;
    }
  }
#pragma unroll
  for (int e = 0; e < 8; ++e) y[e] = silu_f(y[e]);
}

constexpr float K_SCALE = 0.08838834764831845f;

DI void m1_item(const Params& p, int layer, int c, int k, char* smem) {
  char* ws = p.ws; asm volatile("" : "+s"(ws));
  const h16* QKP = (const h16*)(ws + OFF_QKP);
  const h16* MVT = (const h16*)(ws + OFF_MVT);
  const float* GT = (const float*)(ws + OFF_GT);
  h16* UT = (h16*)(ws + OFF_H);
  float* BT = (float*)(ws + OFF_BT);
  float* GM = (float*)(ws + OFF_GM);
  float* NL = (float*)(ws + OFF_NL);
  const int li_ = layer >> 1;
  const int dir = c & 1, hd = (c >> 1) & 3, b = c >> 3;
  const int j0 = chunk_j0(dir, k);
  const size_t R0 = (size_t)b * TB + j0;
  h16* KT = (h16*)smem;
  float* WL = (float*)(smem + 128 * 136 * 2);
  int tid = threadIdx.x; asm volatile("" : "+v"(tid));
  const int lane = tid & 63, w = tid >> 6, r = lane & 31, hh = lane >> 5;
  if (w == 0) {
    const int r0 = 2 * lane, r1 = r0 + 1;
    const int p0 = dir ? 127 - r0 : r0, p1 = dir ? 127 - r1 : r1;
    const float fb = p.ml_f_bias[(li_ * 2 + dir) * 4 + hd];
    const float li0 = GT[(R0 + p0) * 16 + (2 * dir) * 4 + hd], li1 = GT[(R0 + p1) * 16 + (2 * dir) * 4 + hd];
    const float lf0 = logsig_f(GT[(R0 + p0) * 16 + (2 * dir + 1) * 4 + hd] + fb);
    const float lf1 = logsig_f(GT[(R0 + p1) * 16 + (2 * dir + 1) * 4 + hd] + fb);
    float bc0, bc1;
    scan_sum2(lf0, lf1, lane, bc0, bc1);
    const float btot = __shfl(bc1, 63);
    const float g0 = btot - bc0 + li0, g1 = btot - bc1 + li1;
    float gm = fmaxf(g0, g1);
#pragma unroll
    for (int off = 32; off > 0; off >>= 1) gm = fmaxf(gm, __shfl_xor(gm, off));
    WL[p0] = __expf(g0 - gm);
    WL[p1] = __expf(g1 - gm);
    if (lane == 0) { BT[c * NCHUNK + k] = btot; GM[c * NCHUNK + k] = gm; }
  }
  __syncthreads();
  const bool has_prev = (j0 != 0) && (j0 != SEQ);
  const bool has_next = (j0 + 128 != SEQ) && (j0 + 128 != TB);
  const float* cw = p.ml_conv_w + (size_t)li_ * 5 * 1024;
  const float* cb = p.ml_conv_b + (size_t)li_ * 1024;
  const ConvW cvw = load_convw(cw, cb, 512 + hd * 128 + (tid & 15) * 8);
#pragma unroll 4
  for (int it = tid; it < 128 * 16; it += 256) {
    const int pp = it >> 4, ch0 = (it & 15) * 8;
    float y[8];
    conv8w(QKP, R0, pp, 512 + hd * 128 + ch0, has_prev, has_next, cvw, y);
    const float wv = WL[pp] * K_SCALE;
    const int o16 = pp & 15;
    const int ppos = (pp & ~15) | ((o16 & 3) | ((o16 & 4) << 1) | ((o16 & 8) >> 1));
#pragma unroll
    for (int e = 0; e < 8; ++e) KT[(ch0 + e) * 136 + ppos] = (h16)(y[e] * wv);
  }
  __syncthreads();
  if (tid < 128) {
    float s = 0.f;
#pragma unroll 8
    for (int q = 0; q < 128; ++q) s += (float)KT[tid * 136 + q];
    NL[((size_t)c * NCHUNK + k) * 128 + tid] = s;
  }
  f16v acc[4];
#pragma unroll
  for (int d = 0; d < 4; ++d) acc[d] = zero16();
  const h16* vp = MVT + ((size_t)b * 512 + hd * 128 + w * 32 + r) * TB + j0 + hh * 8;
  h8 af[8];
#pragma unroll
  for (int ks = 0; ks < 8; ++ks) af[ks] = *(const h8*)(vp + ks * 16);
  __builtin_amdgcn_sched_barrier(0);
#pragma unroll
  for (int ks = 0; ks < 8; ++ks) {
#pragma unroll
    for (int d = 0; d < 4; ++d) {
      const h8 bb = *(const h8*)(KT + (d * 32 + r) * 136 + ks * 16 + hh * 8);
      acc[d] = MFMA(af[ks], bb, acc[d]);
    }
  }
  h16* up = UT + ((size_t)c * NCHUNK + k) * 16384;
#pragma unroll
  for (int d = 0; d < 4; ++d)
#pragma unroll
    for (int i = 0; i < 16; ++i) up[(w * 32 + crow(i, hh)) * 128 + d * 32 + r] = (h16)acc[d][i];
  __syncthreads();
}

DI void m3_item(const Params& p, int layer, int b, int hd, int kc, char* smem, int dry) {
  char* ws = p.ws; asm volatile("" : "+s"(ws));
  const h16* QKP = (const h16*)(ws + OFF_QKP);
  const h16* MVT = (const h16*)(ws + OFF_MVT);
  const h16* OG = (const h16*)(ws + OFF_OG);
  const float* GT = (const float*)(ws + OFF_GT);
  const h16* UT = (const h16*)(ws + OFF_H);
  const float* MP = (const float*)(ws + OFF_MP);
  const float* NL = (const float*)(ws + OFF_NL);
  h16* GY = (h16*)(ws + OFF_GY);
  const int li_ = layer >> 1;
  const int j0 = kc < 64 ? kc * 128 : SEQ + (kc - 64) * 128;
  const size_t R0 = (size_t)b * TB + j0;
  h16* Qs = (h16*)smem;
  h16* Ks = Qs + 128 * 136;
  float* BC = (float*)(smem + 2 * 128 * 136 * 2);
  float* AA = BC + 128;
  float* MT = AA + 128;
  float* NP = MT + 128;
  int tid = threadIdx.x; asm volatile("" : "+v"(tid));
  const int lane = tid & 63, w = tid >> 6, r = lane & 31, hh = lane >> 5;
  const bool has_prev = (j0 != 0) && (j0 != SEQ);
  const bool has_next = (j0 + 128 != SEQ) && (j0 + 128 != TB);
  const float* cw = p.ml_conv_w + (size_t)li_ * 5 * 1024;
  const float* cb = p.ml_conv_b + (size_t)li_ * 1024;
  const ConvW cvw = load_convw(cw, cb, ((tid & 31) >> 4) * 512 + hd * 128 + (tid & 15) * 8);
#pragma unroll 4
  for (int it = tid; it < 128 * 32; it += 256) {
    const int pp = it >> 5, cg = it & 31, which = cg >> 4, ch0 = (cg & 15) * 8;
    float y[8];
    conv8w(QKP, R0, pp, which * 512 + hd * 128 + ch0, has_prev, has_next, cvw, y);
    h8 o;
    const float sc = which ? K_SCALE : 1.f;
#pragma unroll
    for (int e = 0; e < 8; ++e) o[e] = (h16)(y[e] * sc);
    *(h8*)((which ? Ks : Qs) + pp * 136 + ch0) = o;
  }
  __syncthreads();
  const int tq = w * 32 + r;
  const unsigned qad = (unsigned)(size_t)(Qs + tq * 136 + hh * 8);
#define LOADQ(q) { lds_rd<0>(q[0], qad); lds_rd<32>(q[1], qad); lds_rd<64>(q[2], qad); lds_rd<96>(q[3], qad); \
                   lds_rd<128>(q[4], qad); lds_rd<160>(q[5], qad); lds_rd<192>(q[6], qad); lds_rd<224>(q[7], qad); \
                   LGKM_WAIT8(0, q[0], q[1], q[2], q[3], q[4], q[5], q[6], q[7]); }
  f16v hs[4];
#pragma unroll
  for (int d = 0; d < 4; ++d) hs[d] = zero16();
#pragma unroll 1
  for (int dir = 0; dir < 2; ++dir) {
    const int c = (b * 4 + hd) * 2 + dir;
    const int k = tokchunk_k(dir, kc);
    const float mprev = MP[c * NCHUNK + k];
    if (w == 0) {
      const int r0 = 2 * lane, r1 = r0 + 1;
      const int p0 = dir ? 127 - r0 : r0, p1 = dir ? 127 - r1 : r1;
      const float fb = p.ml_f_bias[(li_ * 2 + dir) * 4 + hd];
      const float li0 = GT[(R0 + p0) * 16 + (2 * dir) * 4 + hd], li1 = GT[(R0 + p1) * 16 + (2 * dir) * 4 + hd];
      const float lf0 = logsig_f(GT[(R0 + p0) * 16 + (2 * dir + 1) * 4 + hd] + fb);
      const float lf1 = logsig_f(GT[(R0 + p1) * 16 + (2 * dir + 1) * 4 + hd] + fb);
      float bc0, bc1, pm0, pm1;
      scan_sum2(lf0, lf1, lane, bc0, bc1);
      const float a0 = li0 - bc0, a1 = li1 - bc1;
      scan_max2(a0, a1, lane, pm0, pm1);
      BC[p0] = bc0; BC[p1] = bc1; AA[p0] = a0; AA[p1] = a1;
      MT[p0] = fmaxf(mprev, pm0); MT[p1] = fmaxf(mprev, pm1);
    } else if (w == 1) {
      NP[lane] = NL[((size_t)c * NCHUNK + k) * 128 + lane];
      NP[lane + 64] = NL[((size_t)c * NCHUNK + k) * 128 + lane + 64];
    }
    __syncthreads();
    const float mt = MT[tq];
    const float wc = __expf(mprev - mt);
    f16v acc[4];
    float qn = 0.f;
    {
    h8 qf[8];
    LOADQ(qf)
    const h16* cp = UT + ((size_t)c * NCHUNK + k) * 16384 + (size_t)r * 128 + hh * 8;
#pragma unroll
    for (int d = 0; d < 4; ++d) {
      acc[d] = zero16();
      h8 cf[8];
#pragma unroll
      for (int kk = 0; kk < 8; ++kk) cf[kk] = *(const h8*)(cp + d * 32 * 128 + kk * 16);
      __builtin_amdgcn_sched_barrier(0);
#pragma unroll
      for (int kk = 0; kk < 8; ++kk) acc[d] = MFMA(cf[kk], qf[kk], acc[d]);
#pragma unroll
      for (int i = 0; i < 16; ++i) acc[d][i] *= wc;
      __builtin_amdgcn_sched_barrier(0);
    }
#pragma unroll
    for (int kk = 0; kk < 8; ++kk)
#pragma unroll
      for (int e = 0; e < 8; ++e) qn += (float)qf[kk][e] * NP[kk * 16 + hh * 8 + e];
    }
    qn += __shfl_xor(qn, 32);
    float den = 0.f;
    const int st0 = dir ? w : 0, st1 = dir ? 4 : w + 1;
#pragma unroll 1
    for (int st = st0; st < st1; ++st) {
      f16v S = zero16();
      {
        h8 qf[8];
        LOADQ(qf)
        h8 kf[8];
#pragma unroll
        for (int kk = 0; kk < 8; ++kk) kf[kk] = *(const h8*)(Ks + (st * 32 + r) * 136 + kk * 16 + hh * 8);
        __builtin_amdgcn_sched_barrier(0);
#pragma unroll
        for (int kk = 0; kk < 8; ++kk) S = MFMA(kf[kk], qf[kk], S);
        __builtin_amdgcn_sched_barrier(0);
      }
      const h16* vb = MVT + ((size_t)b * 512 + hd * 128 + r) * TB + j0 + st * 32 + 8 * hh;
      h8 vf[8];
#pragma unroll
      for (int d = 0; d < 4; ++d) { vf[2 * d] = *(const h8*)(vb + (size_t)d * 32 * TB); vf[2 * d + 1] = *(const h8*)(vb + (size_t)d * 32 * TB + 16); }
      __builtin_amdgcn_sched_barrier(0);
#pragma unroll
      for (int i = 0; i < 16; ++i) {
        const int s = st * 32 + crow(i, hh);
        const bool valid = dir ? (s >= tq) : (s <= tq);
        float wgt = valid ? __expf(AA[s] - mt) * S[i] : 0.f;
        den += wgt;
        S[i] = wgt;
      }
      h8 p0, p1;
#pragma unroll
      for (int j = 0; j < 8; ++j) { p0[j] = (h16)S[j]; p1[j] = (h16)S[8 + j]; }
#pragma unroll
      for (int d = 0; d < 4; ++d) {
        acc[d] = MFMA(vf[2 * d], p0, acc[d]);
        acc[d] = MFMA(vf[2 * d + 1], p1, acc[d]);
      }
    }
    den += __shfl_xor(den, 32);
    den += wc * qn;
    const float dn = fmaxf(fabsf(den), __expf(-(BC[tq] + mt)));
    const float idn = 1.f / dn;
#pragma unroll
    for (int d = 0; d < 4; ++d)
#pragma unroll
      for (int i = 0; i < 16; ++i) hs[d][i] += acc[d][i] * idn;
    __syncthreads();
  }
  float sm = 0.f;
#pragma unroll
  for (int d = 0; d < 4; ++d)
#pragma unroll
    for (int i = 0; i < 16; ++i) sm += hs[d][i];
  sm += __shfl_xor(sm, 32);
  const float mu = sm * (1.f / 128.f);
  float vs = 0.f;
#pragma unroll
  for (int d = 0; d < 4; ++d)
#pragma unroll
    for (int i = 0; i < 16; ++i) { float dlt = hs[d][i] - mu; vs += dlt * dlt; }
  vs += __shfl_xor(vs, 32);
  const float rstd = rsqrtf(vs * (1.f / 128.f) + 1e-5f);
  const float* ng = p.ml_norm_g + (size_t)li_ * 512 + hd * 128;
  const size_t R = R0 + tq;
  if (!dry)
#pragma unroll
  for (int d = 0; d < 4; ++d)
#pragma unroll
    for (int g = 0; g < 4; ++g) {
      const int dv = d * 32 + 8 * g + 4 * hh;
      h16* yp = GY + R * 1024 + hd * 128 + dv;
      const h4 gv = *(const h4*)yp;
      const h4 og = *(const h4*)(OG + R * 512 + hd * 128 + dv);
      h4 ov;
#pragma unroll
      for (int e = 0; e < 4; ++e)
        ov[e] = (h16)((hs[d][4 * g + e] - mu) * rstd * ng[dv + e] * (float)og[e] * (float)gv[e]);
      *(h4*)yp = ov;
    }
}


#undef LOADQ
#define XB_TMO      128
#define XB_XCNT(j)  (256  + 64 * (j))
#define XB_XSUB(j)  (1280 + 64 * (j))
#define XB_XGEN(j)  (2304 + 64 * (j))
#define XB_TOP      3328
#define XB_TOPGEN   3392
#define XCD_BAR_WORDS 3456
#define XB_SPIN_CAP (1u << 22)
#define LAS __attribute__((address_space(3)))
DI unsigned xb_ld(unsigned* p) { return __hip_atomic_load(p, __ATOMIC_RELAXED, __HIP_MEMORY_SCOPE_AGENT); }
DI unsigned xb_add(unsigned* p, unsigned v) { return __hip_atomic_fetch_add(p, v, __ATOMIC_RELAXED, __HIP_MEMORY_SCOPE_AGENT); }
DI unsigned xb_xcc_id() { return (unsigned)__builtin_amdgcn_s_getreg((3 << 11) | 20) & 0xFu; }
#define XB_SPIN(cond, bar) do { unsigned _sp = 0; while (cond) { __builtin_amdgcn_s_sleep(1); \
    if ((++_sp & 255u) == 0u) { if (xb_ld(&(bar)[XB_TMO])) break; if (_sp > XB_SPIN_CAP) { atomicAdd(&(bar)[XB_TMO], 1u); break; } } } } while (0)
struct XcdBarrier { unsigned* bar; unsigned x; volatile LAS unsigned* st; };
DI XcdBarrier xcd_barrier_post(unsigned* bar, volatile LAS unsigned* st) {
  XcdBarrier b; b.bar = bar; b.x = xb_xcc_id(); b.st = st;
  if (threadIdx.x == 0) (void)xb_add(&bar[XB_XCNT(b.x)], 1u);
  return b;
}
DI void xcd_barrier_complete(unsigned* bar, unsigned x, unsigned& nloc, unsigned& nx) {
  const unsigned G = gridDim.x * gridDim.y * gridDim.z;
  unsigned sum, cnt, mine, sp = 0u;
  for (;;) {
    sum = 0u; cnt = 0u; mine = 0u;
#pragma unroll
    for (unsigned j = 0; j < 16; ++j) { const unsigned c = xb_ld(&bar[XB_XCNT(j)]); sum += c; cnt += (c > 0u) ? 1u : 0u; mine = (j == x) ? c : mine; }
    if (sum == G) break;
    __builtin_amdgcn_s_sleep(1);
    if ((++sp & 255u) == 0u) { if (xb_ld(&bar[XB_TMO])) break; if (sp > XB_SPIN_CAP) { atomicAdd(&bar[XB_TMO], 1u); break; } }
  }
  nloc = mine > 0u ? mine : 1u; nx = cnt > 0u ? cnt : 1u;
}
DI void xcd_barrier(const XcdBarrier& b) {
  asm volatile("s_waitcnt vmcnt(0)" ::: "memory");
  __syncthreads();
  if (threadIdx.x == 0) {
    unsigned* bar = b.bar; asm volatile("" : "+s"(bar));
    unsigned bx = b.x; asm volatile("" : "+s"(bx));
    __builtin_amdgcn_s_waitcnt(0);
    unsigned nloc = b.st[0], nx = b.st[1];
    if (nloc == 0u) { xcd_barrier_complete(bar, bx, nloc, nx); b.st[0] = nloc; b.st[1] = nx; }
    const unsigned old = xb_add(&bar[XB_XSUB(bx)], 1u);
    const unsigned gen = old / nloc;
    if (old + 1u == (gen + 1u) * nloc) {
      __builtin_amdgcn_fence(__ATOMIC_RELEASE, "agent");
      asm volatile("s_waitcnt vmcnt(0)" ::: "memory");
      const unsigned og = xb_add(&bar[XB_TOP], 1u);
      const unsigned tg = og / nx;
      if (og + 1u == (tg + 1u) * nx) xb_add(&bar[XB_TOPGEN], 1u);
      else XB_SPIN(xb_ld(&bar[XB_TOPGEN]) == tg, bar);
      __builtin_amdgcn_fence(__ATOMIC_ACQUIRE, "agent");
      xb_add(&bar[XB_XGEN(bx)], 1u);
      asm volatile("s_waitcnt vmcnt(0)" ::: "memory");
    } else {
      XB_SPIN(xb_ld(&bar[XB_XGEN(bx)]) == gen, bar);
      __builtin_amdgcn_fence(__ATOMIC_ACQUIRE, "agent");
      asm volatile("s_waitcnt vmcnt(0)" ::: "memory");
    }
  }
  __syncthreads();
}

__global__ void __launch_bounds__(256, 2) fwd_megakernel(Params p) {
  cg::grid_group grid = cg::this_grid();
  __shared__ __attribute__((aligned(16))) char smem[74240];
  char* ws = p.ws;
  const int tid = threadIdx.x, lane = tid & 63, w = tid >> 6;
  const int nblk = gridDim.x, bid = blockIdx.x;

  h16* WEV = (h16*)(ws + OFF_WEV);
  h16* WOD = (h16*)(ws + OFF_WOD);
  h16* WOUT = (h16*)(ws + OFF_WOUT);
  h16* WUQ = (h16*)(ws + OFF_WUQ);
  h16* WUKV = (h16*)(ws + OFF_WUKV);
  float* MOD = (float*)(ws + OFF_MOD);
  float* RDA = (float*)(ws + OFF_RDA);
  float* RML = (float*)(ws + OFF_RML);
  h16* X16 = (h16*)(ws + OFF_X16);
  h16* GY = (h16*)(ws + OFF_GY);
  h16* H = (h16*)(ws + OFF_H);
  h16* T = (h16*)(ws + OFF_T);

  __shared__ uint4 xb_words;
  unsigned* xbar = (unsigned*)(ws + OFF_BAR);
  if (tid == 0) xb_words = make_uint4(0u, 0u, 0u, 0u);
  if (bid == 0) for (int i = tid; i < XCD_BAR_WORDS; i += 256) xbar[i] = 0u;
  __syncthreads();
  {
    constexpr int N_ADA = 192;
    constexpr int T_EV = 16 * 48, T_OD = 16 * 76, T_OUT = 256, T_UQ = 4 * 12, T_UKV = 2 * 16;
    constexpr int N_TR = 2 * T_EV + 2 * T_OD + 4 * T_OUT + 2 * T_UQ + 2 * T_UKV;
    float* lds = (float*)smem;
    for (int it = bid; it < N_ADA + N_TR; it += nblk) {
      if (it < N_ADA) {
        float* scond = lds;
        float* red = lds + 5120;
        for (int idx = tid; idx < 5120; idx += 256) {
          const int rr = idx >> 10, d = idx & 1023;
          const float v = rr < 4 ? p.c[rr * 1024 + d] : p.c_ctx[d];
          scond[idx] = silu_f(v);
        }
        __syncthreads();
        const int col = it * 64 + (tid & 63), q = tid >> 6;
        const int l = col / 3072, e = col - l * 3072;
        const float* wp = p.ada_w + (size_t)l * 1024 * 3072 + e;
        float a0 = 0, a1 = 0, a2 = 0, a3 = 0, a4 = 0;
        for (int d = q * 256; d < q * 256 + 256; ++d) {
          const float wv = wp[(size_t)d * 3072];
          a0 += scond[d] * wv; a1 += scond[1024 + d] * wv; a2 += scond[2048 + d] * wv;
          a3 += scond[3072 + d] * wv; a4 += scond[4096 + d] * wv;
        }
        red[(q * 5 + 0) * 64 + (tid & 63)] = a0; red[(q * 5 + 1) * 64 + (tid & 63)] = a1;
        red[(q * 5 + 2) * 64 + (tid & 63)] = a2; red[(q * 5 + 3) * 64 + (tid & 63)] = a3;
        red[(q * 5 + 4) * 64 + (tid & 63)] = a4;
        __syncthreads();
        for (int idx = tid; idx < 320; idx += 256) {
          const int rr = idx >> 6, cc = idx & 63;
          const float s = red[(0 * 5 + rr) * 64 + cc] + red[(1 * 5 + rr) * 64 + cc] + red[(2 * 5 + rr) * 64 + cc] + red[(3 * 5 + rr) * 64 + cc];
          const int col2 = it * 64 + cc, l2 = col2 / 3072, e2 = col2 - l2 * 3072;
          MOD[((size_t)l2 * 5 + rr) * 3072 + e2] = s + p.ada_b[l2 * 3072 + e2];
        }
        __syncthreads();
      } else {
        int t = it - N_ADA;
        const float* W; h16* Wt; int K, N, Npad; const float* gk = nullptr;
        if (t < 2 * T_EV) { int i = t / T_EV; t -= i * T_EV; W = p.ev_w_in + (size_t)i * 1024 * EV_IN; Wt = WEV + (size_t)i * EV_INP * 1024; K = 1024; N = EV_IN; Npad = EV_INP; }
        else if ((t -= 2 * T_EV) < 2 * T_OD) { int i = t / T_OD; t -= i * T_OD; W = p.od_w_in + (size_t)i * 1024 * OD_IN; Wt = WOD + (size_t)i * OD_INP * 1024; K = 1024; N = OD_IN; Npad = OD_INP; }
        else if ((t -= 2 * T_OD) < 4 * T_OUT) { int l = t / T_OUT; t -= l * T_OUT; W = ((l & 1) ? p.od_w_out : p.ev_w_out) + (size_t)(l >> 1) * 1024 * 1024; Wt = WOUT + (size_t)l * 1024 * 1024; K = 1024; N = 1024; Npad = 1024; }
        else if ((t -= 4 * T_OUT) < 2 * T_UQ) { int i = t / T_UQ; t -= i * T_UQ; W = p.mla_w_uq + (size_t)i * 256 * 768; Wt = WUQ + (size_t)i * 768 * 256; K = 256; N = 768; Npad = 768; gk = p.mla_q_norm_g + i * 256; }
        else { t -= 2 * T_UQ; int i = t / T_UKV; t -= i * T_UKV; W = p.mla_w_ukv + (size_t)i * 128 * 1024; Wt = WUKV + (size_t)i * 1024 * 128; K = 128; N = 1024; Npad = 1024; gk = p.mla_kv_norm_g + i * 128; }
        const int nK = K >> 6;
        const int kt = t % nK, nt = t / nK, k0 = kt * 64, n0 = nt * 64;
        const int cc = tid & 63, r4 = tid >> 6;
#pragma unroll 4
        for (int i = 0; i < 16; ++i) {
          const int rr = r4 + 4 * i, n = n0 + cc;
          float v = 0.f;
          if (n < N) { v = W[(size_t)(k0 + rr) * N + n]; if (gk) v *= gk[k0 + rr]; }
          lds[rr * 65 + cc] = v;
        }
        __syncthreads();
#pragma unroll 4
        for (int i = 0; i < 16; ++i) {
          const int rr = r4 + 4 * i;
          Wt[(size_t)(n0 + rr) * K + k0 + cc] = (h16)lds[cc * 65 + rr];
        }
        __syncthreads();
      }
    }
    for (int idx = bid * 256 + tid; idx < SEQ * 48; idx += nblk * 256) {
      const int s = idx / 48, i = idx - s * 48;
      const int grow = s >> 6, gcol = s & 63;
      float ang;
      float* dst;
      if (i < 32) {
        const int f = i & 15;
        const float fr = expf(-(float)f * (9.210340371976184f / 16.f));
        ang = (float)(i < 16 ? grow : gcol) * fr;
        dst = RDA + ((size_t)s * 32 + i) * 2;
      } else {
        const int ii = i - 32, f = ii & 7;
        const float fr = expf(-(float)f * (9.210340371976184f / 8.f));
        ang = (float)(ii < 8 ? grow : gcol) * fr;
        dst = RML + ((size_t)s * 16 + ii) * 2;
      }
      const float kf = rintf(ang * 0.15915494309189535f);
      float rr = fmaf(-kf, 6.28125f, ang);
      rr = fmaf(-kf, 1.9353071795864769e-3f, rr);
      dst[0] = cosf(rr);
      dst[1] = sinf(rr);
    }
  }
  grid.sync();
  const XcdBarrier xb = xcd_barrier_post(xbar, (volatile LAS unsigned*)&xb_words);
#ifdef NSYNC_EXTRA
  for (int i_ = 0; i_ < NSYNC_EXTRA; ++i_) xcd_barrier(xb);
#endif
  for (int idx = bid * 256 + tid; idx < NR * 128; idx += nblk * 256) {
    const int R = idx >> 7, c8 = (idx & 127) * 8;
    const int b = R / TB, j = R - b * TB;
    const float* xr = in_row(p, R) + c8;
    const float* md = MOD + (size_t)(j < SEQ ? b : 4) * 3072;
    const float4 x0 = *(const float4*)xr, x1 = *(const float4*)(xr + 4);
    const float4 s0 = *(const float4*)(md + c8), s1 = *(const float4*)(md + c8 + 4);
    const float4 c0 = *(const float4*)(md + 1024 + c8), c1 = *(const float4*)(md + 1024 + c8 + 4);
    h8 o;
    o[0] = (h16)(x0.x * (1.f + c0.x) + s0.x); o[1] = (h16)(x0.y * (1.f + c0.y) + s0.y);
    o[2] = (h16)(x0.z * (1.f + c0.z) + s0.z); o[3] = (h16)(x0.w * (1.f + c0.w) + s0.w);
    o[4] = (h16)(x1.x * (1.f + c1.x) + s1.x); o[5] = (h16)(x1.y * (1.f + c1.y) + s1.y);
    o[6] = (h16)(x1.z * (1.f + c1.z) + s1.z); o[7] = (h16)(x1.w * (1.f + c1.w) + s1.w);
    *(h8*)(H + (size_t)R * 1024 + c8) = o;
  }
  xcd_barrier(xb);

#pragma unroll 1
  for (int layer = 0; layer < 4; ++layer) {
    asm volatile("" : "+s"(ws));
    h16* WEV = (h16*)(ws + OFF_WEV);
    h16* WOD = (h16*)(ws + OFF_WOD);
    h16* WOUT = (h16*)(ws + OFF_WOUT);
    h16* WUQ = (h16*)(ws + OFF_WUQ);
    h16* WUKV = (h16*)(ws + OFF_WUKV);
    float* MOD = (float*)(ws + OFF_MOD);
    float* RDA = (float*)(ws + OFF_RDA);
    float* RML = (float*)(ws + OFF_RML);
    h16* X16 = (h16*)(ws + OFF_X16);
    h16* GY = (h16*)(ws + OFF_GY);
    h16* H = (h16*)(ws + OFF_H);
    h16* T = (h16*)(ws + OFF_T);
    const int li_ = layer >> 1;
    const bool upd = layer < 3;
    if ((layer & 1) == 0) {
      {
        EpiEven epi{p.ev_b_in + (size_t)li_ * EV_IN, RDA, RML, (h16*)(ws + OFF_QK4), (h16*)(ws + OFF_VT),
                    (h16*)(ws + OFF_CQKV), (h16*)(ws + OFF_KR), GY};
        const h16* Bt = WEV + (size_t)li_ * EV_INP * 1024;
        constexpr int NT = EV_INP / 128;
        constexpr int NTW = NT / 2;
        for (int it = bid; it < 264 * NTW; it += nblk) {
          const int x = it & 7, q = it >> 3;
          const int mt = 33 * x + q / NTW, nt = q % NTW;
          gemm_tile_w(H, 1024, Bt, 1024, 1024, mt * 128, nt * 256, smem, epi);
        }
      }
      xcd_barrier(xb);
      {
        int tid = threadIdx.x; asm volatile("" : "+v"(tid)); const int lane = tid & 63, w = tid >> 6; (void)lane; (void)w;
        const h16* CQKV = (const h16*)(ws + OFF_CQKV);
        float* rstd = (float*)(smem + 73728);
#pragma unroll 1
        for (int rep_ = 0; rep_ < NREP_GEMM; ++rep_)
        for (int it = bid; it < 264 * 14; it += nblk) {
          const int mt = it / 14, nt = it - mt * 14;
          const int row0 = mt * 128;
          const bool uq = nt < 6;
          {
            const int rr = tid >> 1, hs = tid & 1;
            const h16* src = CQKV + (size_t)(row0 + rr) * 384 + (uq ? hs * 128 : 256 + hs * 64);
            float ss = 0.f;
            const int n8 = uq ? 16 : 8;
            for (int q = 0; q < n8; ++q) {
              const h8 v = *(const h8*)(src + q * 8);
#pragma unroll
              for (int e = 0; e < 8; ++e) ss += (float)v[e] * (float)v[e];
            }
            ss += __shfl_xor(ss, 1);
            if (hs == 0) rstd[rr] = rsqrtf(ss * (uq ? 1.f / 256.f : 1.f / 128.f) + 1e-6f);
          }
          __syncthreads();
          if (uq) {
            EpiUQ epi{rstd, row0, RML, (h16*)(ws + OFF_QM)};
            gemm_tile(CQKV, 384, WUQ + (size_t)li_ * 768 * 256, 256, 256, row0, nt * 128, smem, epi);
          } else {
            EpiUKV epi{rstd, row0, (h16*)(ws + OFF_KN), (h16*)(ws + OFF_VMT)};
            gemm_tile(CQKV + 256, 384, WUKV + (size_t)li_ * 1024 * 128, 128, 128, row0, (nt - 6) * 128, smem, epi);
          }
          __syncthreads();
        }
      }
      xcd_barrier(xb);
      {
        int tid = threadIdx.x; asm volatile("" : "+v"(tid)); const int lane = tid & 63, w = tid >> 6; (void)lane; (void)w;
        const float lam_init = 0.8f - 0.6f * expf(-0.3f * (float)layer);
        float lam;
        {
          const float* dl = p.da_lambda + (size_t)li_ * 256;
          float s1 = dl[lane] * dl[64 + lane], s2 = dl[128 + lane] * dl[192 + lane];
#pragma unroll
          for (int off = 32; off > 0; off >>= 1) { s1 += __shfl_xor(s1, off); s2 += __shfl_xor(s2, off); }
          lam = expf(s1) - expf(s2) + lam_init;
        }
        constexpr int N_DA = 1024, N_MLA = 1024, N_DAC = 32, N_MLAC = 32;
#ifndef NREP_E4
#define NREP_E4 1
#endif
#pragma unroll 1
        for (int rep = 0; rep < NREP_E4; ++rep) {
        int dry = (rep + 1 < NREP_E4); asm volatile("" : "+s"(dry));
        for (int it = bid; it < N_DA + N_MLA + N_DAC + N_MLAC; it += nblk) {
          if (it < N_DA) {
            const int rd = it >> 9, pair = rd * 8 + (it & 7), qt = (it & 511) >> 3, hd = pair & 3, b = pair >> 2;

#ifndef SKIP_DA
            da_item(p, layer, b, hd, qt * 128, 0, 132, lam, lam_init, smem, dry);
#endif

          } else if (it < N_DA + N_MLA) {
            const int t = it - N_DA;
            const int rd = t >> 9, x = t & 7, slot = (t & 511) >> 3;
            const int pair = rd * 16 + x * 2 + (slot >> 5), qt = slot & 31, hd = pair & 7, b = pair >> 3;

#ifndef SKIP_MLA
            mla_item(p, b, hd, qt * 256, 0, 132, smem, dry);
#endif

          } else if (it < N_DA + N_MLA + N_DAC) {
            const int t = it - N_DA - N_MLA;
            const int qt = t & 1, hd = (t >> 1) & 3, b = t >> 3;

#ifndef SKIP_DA
            da_item(p, layer, b, hd, SEQ + qt * 128, 128, 132, lam, lam_init, smem, dry);
#endif

          } else {
            const int t = it - N_DA - N_MLA - N_DAC;
            const int hd = t & 7, b = t >> 3;

#ifndef SKIP_MLA
            mla_item(p, b, hd, SEQ, 128, 132, smem, dry);
#endif

          }
        }
        }
      }
      xcd_barrier(xb);

    } else {
      {
        EpiOdd epi{p.od_b_in + (size_t)li_ * OD_IN, (h16*)(ws + OFF_QKP), (h16*)(ws + OFF_MVT), (h16*)(ws + OFF_OG),
                   (h16*)(ws + OFF_NAQ), (h16*)(ws + OFF_NAK), (h16*)(ws + OFF_NAVT), GY, (float*)(ws + OFF_GT)};
        const h16* Bt = WOD + (size_t)li_ * OD_INP * 1024;
        constexpr int NT = OD_INP / 128;
        constexpr int NTW = NT / 2;
        for (int it = bid; it < 264 * NTW; it += nblk) {
          const int x = it & 7, q = it >> 3;
          const int mt = 33 * x + q / NTW, nt = q % NTW;
          gemm_tile_w(H, 1024, Bt, 1024, 1024, mt * 128, nt * 256, smem, epi);
        }
      }
      xcd_barrier(xb);
      {
        int tid = threadIdx.x; asm volatile("" : "+v"(tid)); const int lane = tid & 63, w = tid >> 6; (void)lane; (void)w;
        constexpr int N_M1 = NCHAIN * NCHUNK, N_NA = 4 * 128 * 4;
        const int n_nac = upd ? 64 : 0;
#ifndef NREP_O2
#define NREP_O2 1
#endif
#pragma unroll 1
        for (int rep = 0; rep < NREP_O2; ++rep) {
        int dry = (rep + 1 < NREP_O2); asm volatile("" : "+s"(dry));
        constexpr int N_NA_O2 = 448;
        for (int it = bid; it < N_M1 + N_NA_O2; it += nblk) {
          if (it < N_M1) {

#ifndef SKIP_M1
            m1_item(p, layer, it / NCHUNK, it % NCHUNK, smem);
#endif

          } else {
            const int t = it - N_M1;
            const int hp = t & 3, gr = (t >> 2) & 127, b = t >> 9;

#ifndef SKIP_NA
            na_wave(p, layer, b, gr, hp, smem, dry);
#endif

          }
        }
        }
        (void)N_NA; (void)n_nac;
      }
      xcd_barrier(xb);
      {
        int tid = threadIdx.x; asm volatile("" : "+v"(tid)); const int lane = tid & 63, w = tid >> 6; (void)lane; (void)w;
        h16* UT = (h16*)(ws + OFF_H);
        const float* BT = (const float*)(ws + OFF_BT);
        const float* GM = (const float*)(ws + OFF_GM);
        float* MP = (float*)(ws + OFF_MP);
        float* NL = (float*)(ws + OFF_NL);
        for (int idx = bid * 256 + tid; idx < NCHAIN * 4096 + NCHAIN * 128; idx += nblk * 256) {
          if (idx < NCHAIN * 4096) {
            const int c = idx >> 12, e = (idx & 4095) * 4;
            float m = 0.f, C0 = 0.f, C1 = 0.f, C2 = 0.f, C3 = 0.f;
            h16* ub = UT + (size_t)c * NCHUNK * 16384 + e;
#pragma unroll 1
            for (int k0 = 0; k0 < NCHUNK; k0 += 6) {
              h4 u[6];
#pragma unroll
              for (int j = 0; j < 6; ++j) u[j] = *(const h4*)(ub + (size_t)(k0 + j) * 16384);
#pragma unroll
              for (int j = 0; j < 6; ++j) {
                const int k = k0 + j;
                const float bt = BT[c * NCHUNK + k], gm = GM[c * NCHUNK + k];
                const float mn = fmaxf(bt + m, gm);
                const float decay = __expf(bt + m - mn), sc = __expf(gm - mn);
                h4 cv; cv[0] = (h16)C0; cv[1] = (h16)C1; cv[2] = (h16)C2; cv[3] = (h16)C3;
                *(h4*)(ub + (size_t)k * 16384) = cv;
                if (e == 0) MP[c * NCHUNK + k] = m;
                C0 = decay * C0 + sc * (float)u[j][0]; C1 = decay * C1 + sc * (float)u[j][1];
                C2 = decay * C2 + sc * (float)u[j][2]; C3 = decay * C3 + sc * (float)u[j][3];
                m = mn;
              }
            }
          } else {
            const int q = idx - NCHAIN * 4096;
            const int c = q >> 7, e = q & 127;
            float m = 0.f, C = 0.f;
            float* nb = NL + (size_t)c * NCHUNK * 128 + e;
#pragma unroll 1
            for (int k0 = 0; k0 < NCHUNK; k0 += 6) {
              float u[6];
#pragma unroll
              for (int j = 0; j < 6; ++j) u[j] = nb[(k0 + j) * 128];
#pragma unroll
              for (int j = 0; j < 6; ++j) {
                const int k = k0 + j;
                const float bt = BT[c * NCHUNK + k], gm = GM[c * NCHUNK + k];
                const float mn = fmaxf(bt + m, gm);
                const float decay = __expf(bt + m - mn), sc = __expf(gm - mn);
                nb[k * 128] = C;
                C = decay * C + sc * u[j];
                m = mn;
              }
            }
          }
        }
      }
      xcd_barrier(xb);
      {
        const int nkc = upd ? 66 : 64;
#ifndef NREP_M3
#define NREP_M3 1
#endif
#pragma unroll 1
        for (int rep = 0; rep < NREP_M3; ++rep) {
        int dry = (rep + 1 < NREP_M3); asm volatile("" : "+s"(dry));
        for (int it = bid; it < 16 * nkc; it += nblk) {
          const int kc = it % nkc, bh = it / nkc;

#ifndef SKIP_M3
          m3_item(p, layer, bh >> 2, bh & 3, kc, smem, dry);
#endif

        }
        {
          int tid = threadIdx.x; asm volatile("" : "+v"(tid)); const int w = tid >> 6;
          const int n_rest = (2048 - 448) + (upd ? 64 : 0);
          const int nskip = (upd && nblk > 64) ? 32 : 0;
          for (int j = (bid >= nskip ? bid - nskip : n_rest); j < n_rest; j += nblk - nskip) {
            if (j < 2048 - 448) {
              const int t = 448 + j;
              const int hp = t & 3, gr = (t >> 2) & 127, b = t >> 9;
              na_wave(p, layer, b, gr, hp, smem, dry);
            } else {
              const int t = j - (2048 - 448);
              nactx_item(p, t >> 4, (t >> 1) & 7, t & 1, dry);
            }
          }
        }
        }
      }
      xcd_barrier(xb);
    }
    {
      EpiOut epi{p.x, p.ctx, layer, MOD, X16, T};
      const h16* Bt = WOUT + (size_t)layer * 1024 * 1024;
#pragma unroll 1
      for (int rep_ = 0; rep_ < NREP_GEMM; ++rep_)
      for (int it = bid; it < 5 * 512; it += nblk) {
        const int sup = (it >> 9) * 8 + (it & 7), slot = (it & 511) >> 3;
        if (sup >= 33) continue;
        const int mt = sup * 8 + (slot >> 3), nt = slot & 7;
        if (!upd && (mt % 66) >= 64) continue;
        gemm_tile(GY, 1024, Bt, 1024, 1024, mt * 128, nt * 128, smem, epi);
      }
    }
    xcd_barrier(xb);
    {
      int tid2 = threadIdx.x; asm volatile("" : "+v"(tid2));
      const int lane = tid2 & 63, w = tid2 >> 6;
      const float* lg = p.ln_g + layer * 1024;
      const float* lb = p.ln_b + layer * 1024;
      for (int R = bid * 4 + w; R < NR; R += nblk * 4) {
        const int b = R / TB, j = R - b * TB;
        if (!upd && j >= SEQ) continue;
        const h16* tr = T + (size_t)R * 1024;
        float4 v[4];
        float s = 0.f;
#pragma unroll
        for (int q = 0; q < 4; ++q) {
          const h4 th = *(const h4*)(tr + q * 256 + lane * 4);
          v[q].x = (float)th[0]; v[q].y = (float)th[1]; v[q].z = (float)th[2]; v[q].w = (float)th[3];
          s += v[q].x + v[q].y + v[q].z + v[q].w;
        }
#pragma unroll
        for (int off = 32; off > 0; off >>= 1) s += __shfl_xor(s, off);
        const float mu = s * (1.f / 1024.f);
        float vs = 0.f;
#pragma unroll
        for (int q = 0; q < 4; ++q) {
          v[q].x -= mu; v[q].y -= mu; v[q].z -= mu; v[q].w -= mu;
          vs += v[q].x * v[q].x + v[q].y * v[q].y + v[q].z * v[q].z + v[q].w * v[q].w;
        }
#pragma unroll
        for (int off = 32; off > 0; off >>= 1) vs += __shfl_xor(vs, off);
        const float rstd = rsqrtf(vs * (1.f / 1024.f) + 1e-5f);
        const float* md = MOD + ((size_t)(layer + 1) * 5 + (j < SEQ ? b : 4)) * 3072;
#pragma unroll
        for (int q = 0; q < 4; ++q) {
          const int col = q * 256 + lane * 4;
          const float4 g4 = *(const float4*)(lg + col), b4 = *(const float4*)(lb + col);
          float4 xo;
          xo.x = v[q].x * rstd * g4.x + b4.x; xo.y = v[q].y * rstd * g4.y + b4.y;
          xo.z = v[q].z * rstd * g4.z + b4.z; xo.w = v[q].w * rstd * g4.w + b4.w;
          if (upd) {
            h4 xh; xh[0] = (h16)xo.x; xh[1] = (h16)xo.y; xh[2] = (h16)xo.z; xh[3] = (h16)xo.w;
            *(h4*)(X16 + (size_t)R * 1024 + col) = xh;
            const float4 sh = *(const float4*)(md + col), sc = *(const float4*)(md + 1024 + col);
            h4 hh4;
            hh4[0] = (h16)(xo.x * (1.f + sc.x) + sh.x); hh4[1] = (h16)(xo.y * (1.f + sc.y) + sh.y);
            hh4[2] = (h16)(xo.z * (1.f + sc.z) + sh.z); hh4[3] = (h16)(xo.w * (1.f + sc.w) + sh.w);
            *(h4*)(H + (size_t)R * 1024 + col) = hh4;
          } else {
            *(float4*)(p.out + ((size_t)b * SEQ + j) * 1024 + col) = xo;
          }
        }
      }
    }
    if (layer < 3) xcd_barrier(xb);
  }
}

extern "C" void kernel_launch(void* const* d_in, const int* in_sizes, int n_in, void* d_out, int out_size, void* d_ws,
                              size_t ws_size, hipStream_t stream) {
  static int grid_blocks = 0;
  if (!grid_blocks) {
    int dev = 0, cus = 0, per_cu = 0;
    hipGetDevice(&dev);
    hipDeviceGetAttribute(&cus, hipDeviceAttributeMultiprocessorCount, dev);
    hipOccupancyMaxActiveBlocksPerMultiprocessor(&per_cu, fwd_megakernel, 256, 0);
    if (per_cu > 2) per_cu = 2;
    if (per_cu < 1) per_cu = 1;
    grid_blocks = cus * per_cu;
  }
  Params p{};
  const float** pp = (const float**)&p;
  for (int i = 0; i < 25; ++i) pp[i] = (const float*)d_in[i];
  p.out = (float*)d_out;
  p.ws = (char*)d_ws;
  void* args[] = {&p};
  hipError_t e = hipLaunchCooperativeKernel((void*)fwd_megakernel, dim3(grid_blocks), dim3(256), args, 0, stream);
  if (e != hipSuccess) fprintf(stderr, "cooperative launch failed: %s (grid %d)\n", hipGetErrorString(e), grid_blocks);
}
```
